# Optimizing an MI355X kernel written in HIP

```python
import math
import jax, jax.numpy as jnp
from jax import lax
import numpy as np

D_MODEL = 1024
BATCH = 8
SEQ = 4096
DEPTH = 4

D_CONV = D_MODEL // 2
CONV_WIDTH = 3
D_SSM = D_MODEL // 2
SSM_GROUP = 16
N_SSM_GROUPS = D_SSM // SSM_GROUP
SSM_STATE = 64
D_POOL = D_MODEL // 2
POOL_WINDOWS = (2, 4, 8, 16)
POOL_GROUP = D_POOL // len(POOL_WINDOWS)
D_SGU = D_MODEL // 2
SGU_HEADS = 4
SGU_HEAD_DIM = D_SGU // SGU_HEADS
CHUNK = 128
D_FF = ((8 * D_MODEL // 3 + 127) // 128) * 128
N_EVEN = (DEPTH + 1) // 2
N_ODD = DEPTH // 2
EPS = 1e-6

kernel_name = "hybrid_conv_s5_pool_sgu_trunk"


def rmsnorm(x, g):
    xf = x.astype(jnp.float32)
    y = xf * lax.rsqrt(jnp.mean(xf * xf, axis=-1, keepdims=True) + EPS)
    return (y * g.astype(jnp.float32)).astype(x.dtype)


def causal_dwconv(x, w):
    L = x.shape[1]
    K = w.shape[0]
    xp = jnp.pad(x, ((0, 0), (K - 1, 0), (0, 0)))
    y = xp[:, 0:L] * w[0]
    for k in range(1, K):
        y = y + xp[:, k:k + L] * w[k]
    return y


def short_conv_mixer(xa, ba, ca, conv_w):
    return ba * causal_dwconv(ca * xa, conv_w)


def s5_mixer(u, log_step, a_re, a_im, b_re, b_im, c_re, c_im, d_skip, glu_w, glu_b):
    f32 = jnp.float32
    Bsz, L, _ = u.shape
    uf = u.astype(f32).reshape(Bsz, L, N_SSM_GROUPS, SSM_GROUP)
    lam = lax.complex(a_re.astype(f32), a_im.astype(f32))
    step = jnp.exp(log_step.astype(f32))[:, None]
    lam_bar = jnp.exp(lam * step)
    b_tilde = lax.complex(b_re.astype(f32), b_im.astype(f32))
    b_bar = ((lam_bar - 1.0) / lam)[..., None] * b_tilde
    bu = jnp.einsum('gph,blgh->blgp', b_bar, uf.astype(jnp.complex64))
    a_elems = jnp.broadcast_to(lam_bar, bu.shape)

    def combine(left, right):
        a_l, b_l = left
        a_r, b_r = right
        return a_r * a_l, a_r * b_l + b_r

    _, states = lax.associative_scan(combine, (a_elems, bu), axis=1)
    c_tilde = lax.complex(c_re.astype(f32), c_im.astype(f32))
    y = jnp.real(jnp.einsum('ghp,blgp->blgh', c_tilde, states))
    y = y + d_skip.astype(f32).reshape(N_SSM_GROUPS, SSM_GROUP) * uf
    y = jax.nn.gelu(y.reshape(Bsz, L, D_SSM))
    y = y * jax.nn.sigmoid(y @ glu_w.astype(f32) + glu_b.astype(f32))
    return y.astype(u.dtype)


def pool_mixer(z, pool_w, pool_scale):
    f32 = jnp.float32
    Bsz, L, _ = z.shape
    zf = z.astype(f32).reshape(Bsz, L, len(POOL_WINDOWS), POOL_GROUP)
    csum = lax.cumsum(zf, axis=1)
    count = jnp.arange(1, L + 1, dtype=f32)[None, :, None]
    outs = []
    for g, w in enumerate(POOL_WINDOWS):
        s = csum[:, :, g]
        lower = jnp.pad(s, ((0, 0), (w, 0), (0, 0)))[:, :L]
        mean = (s - lower) / jnp.minimum(count, w)
        outs.append(mean - zf[:, :, g])
    pooled = jnp.stack(outs, axis=2)
    y = jnp.einsum('blgc,gcd->blgd', pooled, pool_w.astype(f32)).reshape(Bsz, L, D_POOL)
    return (y * pool_scale.astype(f32)).astype(z.dtype)


def sgu_mixer(su, sv, norm_g, sgu_w, sgu_b):
    Bsz, L, _ = su.shape
    v = rmsnorm(sv, norm_g)
    vr = v.reshape(Bsz, L // CHUNK, CHUNK, SGU_HEADS, SGU_HEAD_DIM)
    mask = jnp.tril(jnp.ones((CHUNK, CHUNK), dtype=bool))
    w_s = jnp.where(mask, sgu_w, 0)
    mixed = jnp.einsum('hts,bnshd->bnthd', w_s, vr) + jnp.swapaxes(sgu_b, 0, 1)[:, :, None]
    return su * mixed.reshape(Bsz, L, D_SGU)


def conv_ffn(h, w_up, conv_w, conv_b, w_down):
    up = causal_dwconv(h @ w_up, conv_w) + conv_b
    g, v = jnp.split(up, 2, axis=-1)
    return (jax.nn.silu(g) * v) @ w_down


def setup_inputs(seed: int = 0) -> dict:
    key = jax.random.key(seed)
    ks = jax.random.split(key, 32)
    f32 = jnp.float32

    def nrm(k, shape, scale):
        return jax.random.normal(k, shape, f32) * scale

    G, P, Hg = N_SSM_GROUPS, SSM_STATE, SSM_GROUP
    d_even_in = 3 * D_CONV + D_SSM
    d_odd_in = D_POOL + 2 * D_SGU
    a_im_base = jnp.pi * jnp.arange(P, dtype=f32)
    return {
        "x": nrm(ks[0], (BATCH, SEQ, D_MODEL), 1.0),
        "norm_mix_g": 1.0 + nrm(ks[1], (DEPTH, D_MODEL), 0.05),
        "even_w_in": nrm(ks[2], (N_EVEN, D_MODEL, d_even_in), D_MODEL ** -0.5),
        "even_conv_w": nrm(ks[3], (N_EVEN, CONV_WIDTH, D_CONV), CONV_WIDTH ** -0.5),
        "ssm_log_step": jax.random.uniform(ks[4], (N_EVEN, G), f32, math.log(1e-3), math.log(1e-1)),
        "ssm_a_re": -0.5 * (1.0 + nrm(ks[5], (N_EVEN, G, P), 0.01)),
        "ssm_a_im": a_im_base + nrm(ks[6], (N_EVEN, G, P), 0.01),
        "ssm_b_re": nrm(ks[7], (N_EVEN, G, P, Hg), (2 * Hg) ** -0.5),
        "ssm_b_im": nrm(ks[8], (N_EVEN, G, P, Hg), (2 * Hg) ** -0.5),
        "ssm_c_re": nrm(ks[9], (N_EVEN, G, Hg, P), (2 * P) ** -0.5),
        "ssm_c_im": nrm(ks[10], (N_EVEN, G, Hg, P), (2 * P) ** -0.5),
        "ssm_d": nrm(ks[11], (N_EVEN, D_SSM), 1.0),
        "ssm_glu_w": nrm(ks[12], (N_EVEN, D_SSM, D_SSM), D_SSM ** -0.5),
        "ssm_glu_b": nrm(ks[13], (N_EVEN, D_SSM), 0.02),
        "even_w_out": nrm(ks[14], (N_EVEN, D_CONV + D_SSM, D_MODEL), (D_CONV + D_SSM) ** -0.5),
        "odd_w_in": nrm(ks[15], (N_ODD, D_MODEL, d_odd_in), D_MODEL ** -0.5),
        "pool_w": nrm(ks[16], (N_ODD, len(POOL_WINDOWS), POOL_GROUP, POOL_GROUP), POOL_GROUP ** -0.5),
        "pool_scale": 1.0 + nrm(ks[17], (N_ODD, D_POOL), 0.1),
        "sgu_norm_g": 1.0 + nrm(ks[18], (N_ODD, D_SGU), 0.05),
        "sgu_w": nrm(ks[19], (N_ODD, SGU_HEADS, CHUNK, CHUNK), CHUNK ** -0.5),
        "sgu_b": 1.0 + nrm(ks[20], (N_ODD, SGU_HEADS, CHUNK), 0.1),
        "odd_w_out": nrm(ks[21], (N_ODD, D_POOL + D_SGU, D_MODEL), (D_POOL + D_SGU) ** -0.5),
        "norm_ffn_g": 1.0 + nrm(ks[22], (DEPTH, D_MODEL), 0.05),
        "ffn_w_up": nrm(ks[23], (DEPTH, D_MODEL, 2 * D_FF), D_MODEL ** -0.5),
        "ffn_conv_w": nrm(ks[24], (DEPTH, CONV_WIDTH, 2 * D_FF), CONV_WIDTH ** -0.5),
        "ffn_conv_b": nrm(ks[25], (DEPTH, 2 * D_FF), 0.02),
        "ffn_w_down": nrm(ks[26], (DEPTH, D_FF, D_MODEL), D_FF ** -0.5),
        "norm_final_g": 1.0 + nrm(ks[27], (D_MODEL,), 0.05),
    }


def reference(x, norm_mix_g, even_w_in, even_conv_w, ssm_log_step, ssm_a_re, ssm_a_im,
              ssm_b_re, ssm_b_im, ssm_c_re, ssm_c_im, ssm_d, ssm_glu_w, ssm_glu_b,
              even_w_out, odd_w_in, pool_w, pool_scale, sgu_norm_g, sgu_w, sgu_b,
              odd_w_out, norm_ffn_g, ffn_w_up, ffn_conv_w, ffn_conv_b, ffn_w_down,
              norm_final_g):
    for i in range(DEPTH):
        h = rmsnorm(x, norm_mix_g[i])
        j = i // 2
        if i % 2 == 0:
            proj = h @ even_w_in[j]
            xa = proj[..., :D_CONV]
            ba = proj[..., D_CONV:2 * D_CONV]
            ca = proj[..., 2 * D_CONV:3 * D_CONV]
            u = proj[..., 3 * D_CONV:]
            ya = short_conv_mixer(xa, ba, ca, even_conv_w[j])
            yb = s5_mixer(u, ssm_log_step[j], ssm_a_re[j], ssm_a_im[j], ssm_b_re[j], ssm_b_im[j],
                          ssm_c_re[j], ssm_c_im[j], ssm_d[j], ssm_glu_w[j], ssm_glu_b[j])
            mix = jnp.concatenate([ya, yb], axis=-1) @ even_w_out[j]
        else:
            proj = h @ odd_w_in[j]
            z = proj[..., :D_POOL]
            uv = jax.nn.gelu(proj[..., D_POOL:])
            su = uv[..., :D_SGU]
            sv = uv[..., D_SGU:]
            yc = pool_mixer(z, pool_w[j], pool_scale[j])
            yd = sgu_mixer(su, sv, sgu_norm_g[j], sgu_w[j], sgu_b[j])
            mix = jnp.concatenate([yc, yd], axis=-1) @ odd_w_out[j]
        x = x + mix
        x = x + conv_ffn(rmsnorm(x, norm_ffn_g[i]), ffn_w_up[i], ffn_conv_w[i], ffn_conv_b[i], ffn_w_down[i])
    return rmsnorm(x, norm_final_g)
```

```cpp
#include <hip/hip_runtime.h>
#include <hip/hip_cooperative_groups.h>
#include <cstdio>
namespace cg = cooperative_groups;

#define LAS __attribute__((address_space(3)))
typedef unsigned short bf16_t;
typedef short bf16x8 __attribute__((ext_vector_type(8)));
typedef float f32x4 __attribute__((ext_vector_type(4)));
typedef unsigned u32x4 __attribute__((ext_vector_type(4)));
typedef unsigned u32x2 __attribute__((ext_vector_type(2)));

constexpr int T = 32768, D = 1024, SEQ = 4096, DFF = 2816, NUP = 5632, TH = 16384;
constexpr float EPS = 1e-6f;
constexpr size_t MiB = 1ull << 20;
constexpr size_t WS_SSQ = 450 * MiB;
constexpr size_t WS_LQ = 2 * MiB;
constexpr size_t WS_W = 4 * MiB;
constexpr size_t WL_STRIDE = 23 * MiB;
constexpr size_t WS_GLU = 96 * MiB;
constexpr size_t WS_POOLW = 97 * MiB;
constexpr size_t WS_SGUW = 97 * MiB + 512 * 1024;
constexpr size_t WS_BCT = 98 * MiB;
constexpr size_t WS_MCT = 102 * MiB;
constexpr size_t WS_XB = 114 * MiB;
constexpr size_t WS_R = 178 * MiB;
constexpr size_t WS_PROJ = WS_R;
constexpr size_t WS_MIX = WS_R + 96 * MiB;
constexpr size_t WS_A2 = WS_R + 160 * MiB;
constexpr size_t WS_SLOC = WS_R + 208 * MiB;
constexpr size_t WS_YG = WS_R + 240 * MiB;
constexpr size_t WS_ACT = WS_R;
constexpr size_t WS_HEAD = 454 * MiB;
constexpr size_t WS_TAIL = 460 * MiB;
constexpr size_t WS_BAR = 3 * MiB;
constexpr size_t WS_BCT2 = 466 * MiB;
constexpr size_t WS_PWBD = 474 * MiB;
constexpr size_t WS_WSBD = 475 * MiB;
constexpr size_t WS_END = 476 * MiB;
constexpr int LDS_STAGE = 131072, LDS_BARW = LDS_STAGE, LDS_HALO = LDS_STAGE + 64, LDS_BYTES = LDS_STAGE + 64 + 8192 + 1024 + 4096;

struct P { const float* in[28]; float* out; unsigned char* ws; };
typedef const __attribute__((address_space(4))) P* PCP;

__device__ __forceinline__ unsigned cvt_pk_bf16(float lo, float hi) { unsigned r; asm volatile("v_cvt_pk_bf16_f32 %0, %1, %2" : "=v"(r) : "v"(lo), "v"(hi)); return r; }
__device__ __forceinline__ bf16_t f2bf(float f) { unsigned u = __float_as_uint(f); u += 0x7FFFu + ((u >> 16) & 1u); return (bf16_t)(u >> 16); }
__device__ __forceinline__ float bflo(unsigned w) { return __uint_as_float(w << 16); }
__device__ __forceinline__ float bfhi(unsigned w) { return __uint_as_float(w & 0xffff0000u); }
__device__ __forceinline__ float sigm(float x) { return __builtin_amdgcn_rcpf(1.0f + __expf(-x)); }
__device__ __forceinline__ float gelu_t(float x) { const float z = 1.5957691216f * (x + 0.044715f * x * x * x); return x * sigm(z); }
__device__ __forceinline__ PCP opqp(PCP q) { asm volatile("" : "+s"(q)); return q; }
__device__ __forceinline__ int opq(int v) { asm volatile("" : "+v"(v)); return v; }
__device__ __forceinline__ float wave_sum(float v) {
#pragma unroll
    for (int o = 32; o >= 1; o >>= 1) v += __shfl_xor(v, o);
    return v;
}
__device__ __forceinline__ void UNPACK8(const u32x4 q, float (&f)[8]) { f[0] = bflo(q.x); f[1] = bfhi(q.x); f[2] = bflo(q.y); f[3] = bfhi(q.y); f[4] = bflo(q.z); f[5] = bfhi(q.z); f[6] = bflo(q.w); f[7] = bfhi(q.w); }


#define XB_TMO      128
#define XB_XCNT(j)  (256  + 64 * (j))
#define XB_XSUB(j)  (1280 + 64 * (j))
#define XB_XGEN(j)  (2304 + 64 * (j))
#define XB_TOP      3328
#define XB_TOPGEN   3392
#define XCD_BAR_WORDS 3456
#define XB_SPIN_CAP (1u << 20)
__device__ __forceinline__ unsigned xb_ld(unsigned* p)              { return __hip_atomic_load(p, __ATOMIC_RELAXED, __HIP_MEMORY_SCOPE_AGENT); }
__device__ __forceinline__ unsigned xb_add(unsigned* p, unsigned v) { return __hip_atomic_fetch_add(p, v, __ATOMIC_RELAXED, __HIP_MEMORY_SCOPE_AGENT); }
__device__ __forceinline__ unsigned xb_xcc_id() { return (unsigned)__builtin_amdgcn_s_getreg((3 << 11) | 20) & 0xFu; }
#define XB_SPIN(cond, bar) do { unsigned _sp = 0; while (cond) { __builtin_amdgcn_s_sleep(1); \
    if ((++_sp & 255u) == 0u) { if (xb_ld(&(bar)[XB_TMO])) break; if (_sp > XB_SPIN_CAP) { atomicAdd(&(bar)[XB_TMO], 1u); break; } } } } while (0)
struct XcdBarrier { unsigned* bar; unsigned x; volatile LAS unsigned* st; };
__device__ __forceinline__ XcdBarrier xcd_barrier_post(unsigned* bar, volatile LAS unsigned* st) {
    XcdBarrier b; b.bar = bar; b.x = 0u; b.st = st;
    if (threadIdx.x == 0) { const unsigned x = xb_xcc_id(); st[2] = x; (void)xb_add(&bar[XB_XCNT(x)], 1u); }
    return b;
}
__device__ __forceinline__ void xcd_barrier_complete(unsigned* bar, unsigned x, unsigned& nloc, unsigned& nx) {
    const unsigned G = gridDim.x * gridDim.y * gridDim.z;
    unsigned sum, cnt, mine, sp = 0u;
    for (;;) {
        sum = 0u; cnt = 0u; mine = 0u;
#pragma unroll
        for (unsigned j = 0; j < 16; ++j) { const unsigned c = xb_ld(&bar[XB_XCNT(j)]); sum += c; cnt += (c > 0u) ? 1u : 0u; mine = (j == x) ? c : mine; }
        if (sum == G) break;
        __builtin_amdgcn_s_sleep(1);
        if ((++sp & 255u) == 0u) { if (xb_ld(&bar[XB_TMO])) break; if (sp > XB_SPIN_CAP) { atomicAdd(&bar[XB_TMO], 1u); break; } }
    }
    nloc = mine > 0u ? mine : 1u; nx = cnt > 0u ? cnt : 1u;
}
__device__ __forceinline__ void xcd_barrier(const XcdBarrier& b) {
    asm volatile("s_waitcnt vmcnt(0) lgkmcnt(0)" ::: "memory");
    __syncthreads();
    if (threadIdx.x == 0) {
        unsigned* bar = b.bar;
        __builtin_amdgcn_s_waitcnt(0);
        unsigned nloc = b.st[0], nx = b.st[1]; const unsigned bx = b.st[2];
        if (nloc == 0u) { xcd_barrier_complete(bar, bx, nloc, nx); b.st[0] = nloc; b.st[1] = nx; }
        const unsigned old = xb_add(&bar[XB_XSUB(bx)], 1u);
        const unsigned gen = old / nloc;
        if (old + 1u == (gen + 1u) * nloc) {
            __builtin_amdgcn_fence(__ATOMIC_RELEASE, "agent");
            asm volatile("s_waitcnt vmcnt(0)" ::: "memory");
            const unsigned og = xb_add(&bar[XB_TOP], 1u);
            const unsigned tg = og / nx;
            if (og + 1u == (tg + 1u) * nx) xb_add(&bar[XB_TOPGEN], 1u);
            else XB_SPIN(xb_ld(&bar[XB_TOPGEN]) == tg, bar);
            __builtin_amdgcn_fence(__ATOMIC_ACQUIRE, "agent");
            xb_add(&bar[XB_XGEN(bx)], 1u);
            asm volatile("s_waitcnt vmcnt(0)" ::: "memory");
        } else {
            XB_SPIN(xb_ld(&bar[XB_XGEN(bx)]) == gen, bar);
            __builtin_amdgcn_fence(__ATOMIC_ACQUIRE, "agent");
            asm volatile("s_waitcnt vmcnt(0)" ::: "memory");
        }
    }
    __syncthreads();
}

namespace pg8 {
constexpr int BM = 256, BK = 64, HALF = 128, HTB = HALF * BK * 2, STAGE_BYTES = 8 * HTB, NXCD = 8, WGM = 8;
__device__ __forceinline__ int lds_byte(int r, int c) { const int st = (r >> 4) * 2 + (c >> 5), rr = r & 15, cc = c & 31, ob = rr * 64 + cc * 2; return st * 1024 + (ob ^ (((ob >> 9) & 1) << 5)); }
__device__ __forceinline__ void stage_rc(int b, int& R, int& C) { const int st = b / 1024, sb = b % 1024, swz = sb ^ (((sb >> 9) & 1) << 5); R = (st >> 1) * 16 + swz / 64; C = (st & 1) * 32 + (swz % 64) / 2; }
__device__ __forceinline__ int perm32(int rho) { const int n = rho >> 4, i = rho & 15; return 8 * (i >> 2) + 4 * n + (i & 3); }

struct Unit { int pm, pn; };
struct Gemm { const bf16_t* A; const bf16_t* Bt; int M, N, K, lda, ldb; };

struct StaticOrder {
    int nM, nN, nwg, G, c, diag;
    __device__ void init(int M, int N, int G_, int c_) { nM = M / BM; nN = N / BM; nwg = nM * nN; G = G_; c = c_; diag = 0; }
    __device__ void init_diag(int nunits, int G_, int c_) { nM = nunits; nN = 1; nwg = nunits; G = G_; c = c_; diag = 1; }
    __device__ bool next(int i, Unit& u) const {
        const long L = (long)i * G + c; if (L >= nwg) return false;
        if (diag) { u.pm = (int)L; u.pn = (int)(L >> 3); return true; }
        int wgid = (int)L; { const int q = nwg / NXCD, r = nwg % NXCD, xcd = wgid % NXCD, off = wgid / NXCD; wgid = (xcd < r ? xcd * (q + 1) : r * (q + 1) + (xcd - r) * q) + off; }
        const int nig = WGM * nN, gid = wgid / nig, fm = gid * WGM, gsz = (nM - fm) < WGM ? (nM - fm) : WGM;
        u.pm = fm + ((wgid % nig) % gsz); u.pn = (wgid % nig) / gsz; return true;
    }
};

template <class Epi>
__device__ __forceinline__ void gemm_phase(LAS unsigned char* lds, const Gemm g, const StaticOrder& S, const Epi& E) {
    const int tid = opq(threadIdx.x), wid = __builtin_amdgcn_readfirstlane(tid >> 6), lane = tid & 63, wr = wid >> 2, wc = wid & 3, fr = lane & 15, fq = lane >> 4;
    const int K = g.K, nt = K / BK;
    unsigned voffA[2], voffB[2];
#pragma unroll
    for (int i = 0; i < 2; ++i) { int R, C; stage_rc(tid * 16 + i * 8192, R, C); const int Rb = (R & ~31) + perm32(R & 31);
        voffA[i] = (unsigned)(R * g.lda + C) * 2u; voffB[i] = (unsigned)(Rb * g.ldb + C) * 2u; }
    const size_t kstep = (size_t)(BK * 2);
    const size_t hstepA = (size_t)HALF * g.lda * 2, hstepB = (size_t)HALF * g.ldb * 2;
    const size_t tstepA = 2 * hstepA, tstepB = 2 * hstepB;
    const unsigned ldsw = (unsigned)wid * 1024u;
    const int aoff = lds_byte(wr * 64 + fr, fq * 8), boff = lds_byte(wc * 32 + fr, fq * 8);
#define PG8_SA(b, h) (((b) * 2 + (h)) * HTB)
#define PG8_SB(b, h) ((4 + (b) * 2 + (h)) * HTB)
#define PG8_STAGE(bufoff, gbase, voff) do { _Pragma("unroll") for (int _i = 0; _i < 2; ++_i) \
        __builtin_amdgcn_global_load_lds((const unsigned*)((const char*)(gbase) + (voff)[_i]), (LAS unsigned*)(lds + (bufoff) + ldsw + _i * 8192), 16, 0, 0); } while (0)
#define PG8_LDA(dst, b, h) do { _Pragma("unroll") for (int m = 0; m < 4; ++m) _Pragma("unroll") for (int k = 0; k < 2; ++k) dst[m][k] = *(const LAS bf16x8*)(lds + PG8_SA(b, h) + aoff + m * 2048 + k * 1024); } while (0)
#define PG8_LDB(dst, b, h) do { _Pragma("unroll") for (int n = 0; n < 2; ++n) _Pragma("unroll") for (int k = 0; k < 2; ++k) dst[n][k] = *(const LAS bf16x8*)(lds + PG8_SB(b, h) + boff + n * 2048 + k * 1024); } while (0)
#define PG8_MMA(ai, bj, At, Bt) do { __builtin_amdgcn_s_setprio(1); _Pragma("unroll") for (int m = 0; m < 4; ++m) _Pragma("unroll") for (int n = 0; n < 2; ++n) _Pragma("unroll") for (int k = 0; k < 2; ++k) \
        acc[ai][bj][m][n] = __builtin_amdgcn_mfma_f32_16x16x32_bf16(Bt[n][k], At[m][k], acc[ai][bj][m][n], 0, 0, 0); __builtin_amdgcn_s_setprio(0); } while (0)
#define PG8_WAIT_V(n) asm volatile("s_waitcnt vmcnt(" #n ")" ::: "memory")
#define PG8_WAIT_L(n) asm volatile("s_waitcnt lgkmcnt(" #n ")" ::: "memory")
#define PG8_BAR __builtin_amdgcn_s_barrier()
#define PG8_SCHED __builtin_amdgcn_sched_barrier(0)
    Unit cur, nxt; int ui = 0;
    if (!S.next(0, cur)) return;
    f32x4 acc[2][2][4][2];
#pragma unroll
    for (int a = 0; a < 2; ++a)
#pragma unroll
        for (int b = 0; b < 2; ++b)
#pragma unroll
            for (int m = 0; m < 4; ++m)
#pragma unroll
                for (int n = 0; n < 2; ++n) acc[a][b][m][n] = (f32x4){0.f, 0.f, 0.f, 0.f};
    bf16x8 At[4][2], B0[2][2], B1[2][2];
    const char* cA = (const char*)g.A + (size_t)cur.pm * tstepA; const char* cB = (const char*)g.Bt + (size_t)cur.pn * tstepB;
    PG8_STAGE(PG8_SB(0, 0), cB, voffB); PG8_STAGE(PG8_SB(0, 1), cB + hstepB, voffB); PG8_STAGE(PG8_SA(0, 0), cA, voffA); PG8_STAGE(PG8_SA(0, 1), cA + hstepA, voffA);
    if (wr == 1) PG8_BAR;
    PG8_WAIT_V(2); PG8_BAR;
    PG8_STAGE(PG8_SB(1, 0), cB + kstep, voffB); PG8_STAGE(PG8_SA(1, 0), cA + kstep, voffA); PG8_STAGE(PG8_SB(1, 1), cB + hstepB + kstep, voffB);
    PG8_WAIT_V(6); PG8_BAR;
    for (;;) {
        const bool has_next = S.next(ui + 1, nxt);
        const char* nA = has_next ? (const char*)g.A + (size_t)nxt.pm * tstepA : cA; const char* nB = has_next ? (const char*)g.Bt + (size_t)nxt.pn * tstepB : cB;
        for (int t = 0; t < nt; t += 2) {
            const bool last = (t == nt - 2);
            const char* a1 = cA + (size_t)(t + 1) * kstep;
            const char* a2 = last ? nA : cA + (size_t)(t + 2) * kstep; const char* b2 = last ? nB : cB + (size_t)(t + 2) * kstep;
            const char* a3 = a2 + kstep; const char* b3 = b2 + kstep;
            PG8_LDB(B0, 0, 0); PG8_LDB(B1, 0, 1); PG8_SCHED; PG8_LDA(At, 0, 0); PG8_STAGE(PG8_SA(1, 1), a1 + hstepA, voffA);
            PG8_WAIT_V(8); PG8_WAIT_L(0); PG8_BAR; PG8_MMA(0, 0, At, B0); PG8_MMA(0, 1, At, B1); PG8_BAR; PG8_SCHED;
            PG8_LDA(At, 0, 1); PG8_STAGE(PG8_SB(0, 0), b2, voffB); PG8_STAGE(PG8_SB(0, 1), b2 + hstepB, voffB); PG8_STAGE(PG8_SA(0, 0), a2, voffA);
            PG8_WAIT_V(8); PG8_WAIT_L(0); PG8_BAR; PG8_MMA(1, 0, At, B0); PG8_MMA(1, 1, At, B1); PG8_BAR; PG8_SCHED;
            PG8_LDB(B0, 1, 0); PG8_LDB(B1, 1, 1); PG8_SCHED; PG8_LDA(At, 1, 0); PG8_STAGE(PG8_SA(0, 1), a2 + hstepA, voffA);
            PG8_WAIT_V(8); PG8_WAIT_L(0); PG8_BAR; PG8_MMA(0, 0, At, B0); PG8_MMA(0, 1, At, B1); PG8_BAR; PG8_SCHED;
            PG8_LDA(At, 1, 1); PG8_STAGE(PG8_SB(1, 0), b3, voffB); PG8_STAGE(PG8_SB(1, 1), b3 + hstepB, voffB); PG8_STAGE(PG8_SA(1, 0), a3, voffA);
            PG8_WAIT_V(8); PG8_WAIT_L(0); PG8_BAR; PG8_MMA(1, 0, At, B0); PG8_MMA(1, 1, At, B1); PG8_BAR; PG8_SCHED;
        }
        if (wr == 0) PG8_BAR;
        E(acc, cur, wr, wc, fr, fq);
        if (!has_next) break;
#pragma unroll
        for (int a = 0; a < 2; ++a)
#pragma unroll
            for (int b = 0; b < 2; ++b)
#pragma unroll
                for (int m = 0; m < 4; ++m)
#pragma unroll
                    for (int n = 0; n < 2; ++n) acc[a][b][m][n] = (f32x4){0.f, 0.f, 0.f, 0.f};
        cur = nxt; cA = nA; cB = nB; ++ui;
        if (wr == 1) PG8_BAR;
    }
    PG8_WAIT_V(0);
    PG8_BAR;
#undef PG8_SA
#undef PG8_SB
#undef PG8_STAGE
#undef PG8_LDA
#undef PG8_LDB
#undef PG8_MMA
#undef PG8_WAIT_V
#undef PG8_WAIT_L
#undef PG8_BAR
#undef PG8_SCHED
}
}
using pg8::Unit;

__device__ __forceinline__ float row_rstd(const float* ssq, int row, int fq) {
    const f32x4 q = *(const f32x4*)(ssq + (size_t)row * 16 + 4 * fq); float s = (q[0] + q[1]) + (q[2] + q[3]);
    s += __shfl_xor(s, 16); s += __shfl_xor(s, 32); return rsqrtf(s * (1.0f / 1024.0f) + EPS);
}
#define EPI_ROWCOL() const int row0 = u.pm * 256 + wr * 64 + fr, col0 = u.pn * 256 + wc * 32 + 8 * fq
#define EPI_FOR_ROWS() _Pragma("unroll") for (int ai = 0; ai < 2; ++ai) _Pragma("unroll") for (int m = 0; m < 4; ++m)

struct EpiProjOdd {
    bf16_t* proj; const float* ssq;
    __device__ __forceinline__ void operator()(const f32x4 (&acc)[2][2][4][2], const Unit& u, int wr, int wc, int fr, int fq) const {
        EPI_ROWCOL();
        EPI_FOR_ROWS() {
            const int row = row0 + ai * 128 + m * 16; const float rs = row_rstd(ssq, row, fq);
#pragma unroll
            for (int bj = 0; bj < 2; ++bj) { const int col = col0 + bj * 128; f32x4 v0 = acc[ai][bj][m][0] * rs, v1 = acc[ai][bj][m][1] * rs;
                if (u.pn >= 2) {
#pragma unroll
                    for (int e = 0; e < 4; ++e) { v0[e] = gelu_t(v0[e]); v1[e] = gelu_t(v1[e]); } }
                u32x4 w; w.x = cvt_pk_bf16(v0[0], v0[1]); w.y = cvt_pk_bf16(v0[2], v0[3]); w.z = cvt_pk_bf16(v1[0], v1[1]); w.w = cvt_pk_bf16(v1[2], v1[3]);
                *(u32x4*)(proj + (size_t)row * 1536 + col) = w; }
        }
    }
};
__device__ __forceinline__ f32x4 ror4(const f32x4 v, const int which) {
    f32x4 r;
#pragma unroll
    for (int e = 0; e < 4; ++e) { const int x = __float_as_int(v[e]); r[e] = __int_as_float(which == 1 ? __builtin_amdgcn_update_dpp(x, x, 0x121, 0xf, 0xf, false) : __builtin_amdgcn_update_dpp(x, x, 0x122, 0xf, 0xf, false)); }
    return r;
}
struct EpiProjEven4 {
    bf16_t* mix; bf16_t* a2; const float* ssq; const float* cw; float* head; float* tail; LAS float* hl;
    __device__ __forceinline__ void operator()(f32x4 (&acc)[2][2][4][2], const Unit& u, int wr, int wc, int fr, int fq) const {
        fr = opq(fr); fq = opq(fq);
        const int row0 = u.pm * 256 + wr * 64 + fr, ch = u.pn * 64 + wc * 16 + fq * 4;
        EPI_FOR_ROWS() { const int row = row0 + ai * 128 + m * 16; const float rs = row_rstd(ssq, row, fq);
            acc[ai][0][m][0] = (acc[ai][0][m][0] * rs) * (acc[ai][0][m][1] * rs); acc[ai][1][m][0] *= rs;
            const f32x4 uu = acc[ai][1][m][1] * rs; u32x2 w; w.x = cvt_pk_bf16(uu[0], uu[1]); w.y = cvt_pk_bf16(uu[2], uu[3]);
            *(u32x2*)(a2 + ((size_t)(ch >> 4) * 2048 + (row >> 4)) * 384 + (row & 15) * 16 + (ch & 15)) = w; }
        if (fr >= 14) {
#pragma unroll
            for (int ai = 0; ai < 2; ++ai) *(LAS f32x4*)(hl + ((((ai * 2 + wr) * 4 + wc) * 2 + (fr - 14)) * 16 + fq * 4)) = acc[ai][0][3][0];
            if (wr == 1) *(f32x4*)(tail + ((size_t)u.pm * 2 + (fr - 14)) * 512 + ch) = acc[1][0][3][0]; }
        if (wr == 0 && fr < 2) { *(f32x4*)(head + (((size_t)u.pm * 2 + fr) * 2 + 0) * 512 + ch) = acc[0][0][0][0]; *(f32x4*)(head + (((size_t)u.pm * 2 + fr) * 2 + 1) * 512 + ch) = acc[0][1][0][0]; }
        asm volatile("s_waitcnt lgkmcnt(0)" ::: "memory"); __builtin_amdgcn_s_barrier(); asm volatile("" ::: "memory");
        const f32x4 w0 = *(const f32x4*)(cw + ch), w1 = *(const f32x4*)(cw + 512 + ch), w2 = *(const f32x4*)(cw + 1024 + ch);
        const bool seq0 = (u.pm & 15) == 0;
#pragma unroll
        for (int ai = 0; ai < 2; ++ai)
#pragma unroll
            for (int m = 0; m < 4; ++m) {
                const f32x4 cur = acc[ai][0][m][0]; f32x4 p1 = ror4(cur, 1), p2 = ror4(cur, 2);
                if (m > 0) { const f32x4 pv = acc[ai][0][m - 1][0]; const f32x4 q1 = ror4(pv, 1), q2 = ror4(pv, 2);
#pragma unroll
                    for (int e = 0; e < 4; ++e) { p1[e] = (fr == 0) ? q1[e] : p1[e]; p2[e] = (fr < 2) ? q2[e] : p2[e]; } }
                else { f32x4 h14 = (f32x4){0.f, 0.f, 0.f, 0.f}, h15 = h14;
                    if (!(wr == 0 && ai == 0)) { const int sai = (wr == 1) ? ai : 0, swr = (wr == 1) ? 0 : 1; const LAS float* hp = hl + ((((sai * 2 + swr) * 4 + wc) * 2 + 0) * 16 + fq * 4);
                        h14 = *(const LAS f32x4*)hp; h15 = *(const LAS f32x4*)(hp + 16); }
#pragma unroll
                    for (int e = 0; e < 4; ++e) { p1[e] = (fr == 0) ? h15[e] : p1[e]; p2[e] = (fr == 0) ? h14[e] : ((fr == 1) ? h15[e] : p2[e]); } }
                const f32x4 ya = acc[ai][1][m][0] * (w0 * p2 + w1 * p1 + w2 * cur);
                u32x2 w; w.x = cvt_pk_bf16(ya[0], ya[1]); w.y = cvt_pk_bf16(ya[2], ya[3]);
                const bool edge = (wr == 0 && ai == 0 && m == 0 && fr < 2 && !seq0);
                if (!edge) *(u32x2*)(mix + (size_t)(row0 + ai * 128 + m * 16) * 1024 + ch) = w;
            }
    }
};
struct EpiUpFused {
    bf16_t* act; const float* ssq; const float* cw; const float* cb; float* head; float* tail; LAS float* hl;
    __device__ __forceinline__ void operator()(f32x4 (&acc)[2][2][4][2], const Unit& u, int wr, int wc, int fr, int fq) const {
        fr = opq(fr); fq = opq(fq);
        const int row0 = u.pm * 256 + wr * 64 + fr, colg0 = u.pn * 128 + wc * 32 + 8 * fq;
        LAS float* rsL = hl + 2048; LAS float* cwL = hl + 2304;
        { const int t = (wc * 4 + fq) * 16 + fr;
          if (wr == 0) { const float* sp = ssq + ((size_t)u.pm * 256 + t) * 16; const f32x4 a = *(const f32x4*)sp, b = *(const f32x4*)(sp + 4), c = *(const f32x4*)(sp + 8), d = *(const f32x4*)(sp + 12);
              const f32x4 q = (a + b) + (c + d); rsL[t] = rsqrtf(((q[0] + q[1]) + (q[2] + q[3])) * (1.0f / 1024.0f) + EPS); }
          else { const int which = t >> 6, j = (t & 63) * 4, bj = j >> 7, c = j & 127; const float* src = (which < 3 ? cw + (size_t)which * NUP : cb) + bj * DFF + u.pn * 128 + c;
              *(LAS f32x4*)(cwL + which * 256 + j) = *(const f32x4*)src; } }
        if (fr >= 14) {
#pragma unroll
            for (int ai = 0; ai < 2; ++ai)
#pragma unroll
                for (int bj = 0; bj < 2; ++bj)
#pragma unroll
                    for (int n = 0; n < 2; ++n) *(LAS f32x4*)(hl + (((((ai * 2 + wr) * 4 + wc) * 2 + (fr - 14)) * 2 + bj) * 32 + 8 * fq + 4 * n)) = acc[ai][bj][3][n]; }
        asm volatile("s_waitcnt vmcnt(0) lgkmcnt(0)" ::: "memory"); __builtin_amdgcn_s_barrier(); asm volatile("" ::: "memory"); __builtin_amdgcn_s_barrier(); asm volatile("" ::: "memory");
        EPI_FOR_ROWS() { const float rs = rsL[ai * 128 + wr * 64 + m * 16 + fr];
#pragma unroll
            for (int bj = 0; bj < 2; ++bj) { acc[ai][bj][m][0] *= rs; acc[ai][bj][m][1] *= rs; } }
        if (wr == 1 && fr >= 14) {
#pragma unroll
            for (int bj = 0; bj < 2; ++bj)
#pragma unroll
                for (int n = 0; n < 2; ++n) *(f32x4*)(tail + ((size_t)u.pm * 2 + (fr - 14)) * NUP + bj * DFF + colg0 + 4 * n) = acc[1][bj][3][n]; }
        if (wr == 0 && fr < 2) {
#pragma unroll
            for (int bj = 0; bj < 2; ++bj)
#pragma unroll
                for (int n = 0; n < 2; ++n) *(f32x4*)(head + ((size_t)u.pm * 2 + fr) * NUP + bj * DFF + colg0 + 4 * n) = acc[0][bj][0][n]; }
        const bool seq0 = (u.pm & 15) == 0;
#pragma unroll
        for (int n = 0; n < 2; ++n) {
            const int lc = wc * 32 + 8 * fq + 4 * n + opq(0);
            const f32x4 wg0 = *(const LAS f32x4*)(cwL + lc), wg1 = *(const LAS f32x4*)(cwL + 256 + lc), wg2 = *(const LAS f32x4*)(cwL + 512 + lc), bg = *(const LAS f32x4*)(cwL + 768 + lc);
            const f32x4 wv0 = *(const LAS f32x4*)(cwL + 128 + lc), wv1 = *(const LAS f32x4*)(cwL + 384 + lc), wv2 = *(const LAS f32x4*)(cwL + 640 + lc), bv = *(const LAS f32x4*)(cwL + 896 + lc);
#pragma unroll
            for (int ai = 0; ai < 2; ++ai)
#pragma unroll
                for (int m = 0; m < 4; ++m) {
                    f32x4 gv[2];
#pragma unroll
                    for (int bj = 0; bj < 2; ++bj) {
                        const f32x4 cur = acc[ai][bj][m][n]; f32x4 p1 = ror4(cur, 1), p2 = ror4(cur, 2);
                        if (m > 0) { const f32x4 pv = acc[ai][bj][m - 1][n]; const f32x4 q1 = ror4(pv, 1), q2 = ror4(pv, 2);
#pragma unroll
                            for (int e = 0; e < 4; ++e) { p1[e] = (fr == 0) ? q1[e] : p1[e]; p2[e] = (fr < 2) ? q2[e] : p2[e]; } }
                        else { f32x4 h14 = (f32x4){0.f, 0.f, 0.f, 0.f}, h15 = h14;
                            if (!(wr == 0 && ai == 0)) { const int sai = (wr == 1) ? ai : 0, swr = (wr == 1) ? 0 : 1; const int ox = opq(0);
                                const LAS float* hp = hl + (((((sai * 2 + swr) * 4 + wc) * 2 + 0) * 2 + bj) * 32 + 8 * fq + 4 * n) + ox;
                                const float r14 = rsL[sai * 128 + swr * 64 + 62 + ox], r15 = rsL[sai * 128 + swr * 64 + 63 + ox];
                                h14 = *(const LAS f32x4*)hp * r14; h15 = *(const LAS f32x4*)(hp + 64) * r15; }
#pragma unroll
                            for (int e = 0; e < 4; ++e) { p1[e] = (fr == 0) ? h15[e] : p1[e]; p2[e] = (fr == 0) ? h14[e] : ((fr == 1) ? h15[e] : p2[e]); } }
                        const f32x4 w0 = bj ? wv0 : wg0, w1 = bj ? wv1 : wg1, w2 = bj ? wv2 : wg2, bb = bj ? bv : bg;
                        gv[bj] = bb + w0 * p2 + w1 * p1 + w2 * cur;
                    }
                    float o[4];
#pragma unroll
                    for (int e = 0; e < 4; ++e) o[e] = gv[0][e] * sigm(gv[0][e]) * gv[1][e];
                    u32x2 w; w.x = cvt_pk_bf16(o[0], o[1]); w.y = cvt_pk_bf16(o[2], o[3]);
                    const bool edge = (wr == 0 && ai == 0 && m == 0 && fr < 2 && !seq0);
                    if (!edge) *(u32x2*)(act + (size_t)(row0 + ai * 128 + m * 16) * DFF + colg0 + 4 * n) = w;
                    __builtin_amdgcn_sched_barrier(0);
                }
        }
    }
};
struct EpiS5a {
    static constexpr bool PF = false;
    float* sloc;
    __device__ __forceinline__ void operator()(const f32x4 (&acc)[2][2][4][2], const Unit& u, int wr, int wc, int fr, int fq) const {
        const int row0 = u.pm * 256 + wr * 64 + fr, col0 = wc * 32 + 8 * fq;
        EPI_FOR_ROWS() { float* rp = sloc + (size_t)(row0 + ai * 128 + m * 16) * 128 + col0; *(f32x4*)rp = acc[ai][0][m][0]; *(f32x4*)(rp + 4) = acc[ai][0][m][1]; }
    }
};
struct EpiPoolOut {
    static constexpr bool PF = false;
    bf16_t* mix;
    __device__ __forceinline__ void operator()(const f32x4 (&acc)[2][2][4][2], const Unit& u, int wr, int wc, int fr, int fq) const {
        EPI_ROWCOL();
        EPI_FOR_ROWS() {
#pragma unroll
            for (int bj = 0; bj < 2; ++bj) { const f32x4 v0 = acc[ai][bj][m][0], v1 = acc[ai][bj][m][1];
                u32x4 w; w.x = cvt_pk_bf16(v0[0], v0[1]); w.y = cvt_pk_bf16(v0[2], v0[3]); w.z = cvt_pk_bf16(v1[0], v1[1]); w.w = cvt_pk_bf16(v1[2], v1[3]);
                *(u32x4*)(mix + (size_t)(row0 + ai * 128 + m * 16) * 1024 + col0 + bj * 128) = w; } }
    }
};
struct EpiSguOut {
    static constexpr bool PF = false;
    const bf16_t* proj; const float* sb; bf16_t* mix;
    __device__ __forceinline__ void operator()(const f32x4 (&acc)[2][2][4][2], const Unit& u, int wr, int wc, int fr, int fq) const {
        EPI_ROWCOL();
        EPI_FOR_ROWS() { const int r = row0 + ai * 128 + m * 16, h = r >> 7, t = r & 127; const float bb = sb[r];
#pragma unroll
            for (int bj = 0; bj < 2; ++bj) { const int c = col0 + bj * 128, chunk = c >> 7, d = c & 127; const size_t tok = (size_t)chunk * 128 + t;
                const u32x4 sw = *(const u32x4*)(proj + tok * 1536 + 512 + h * 128 + d); float su[8]; UNPACK8(sw, su); const f32x4 a0 = acc[ai][bj][m][0] + bb, a1 = acc[ai][bj][m][1] + bb;
                u32x4 w; w.x = cvt_pk_bf16(a0[0] * su[0], a0[1] * su[1]); w.y = cvt_pk_bf16(a0[2] * su[2], a0[3] * su[3]); w.z = cvt_pk_bf16(a1[0] * su[4], a1[1] * su[5]); w.w = cvt_pk_bf16(a1[2] * su[6], a1[3] * su[7]);
                *(u32x4*)(mix + tok * 1024 + 512 + h * 128 + d) = w; } }
    }
};
struct EpiS5c {
    const bf16_t* a2; const float* dsk; bf16_t* yg;
    __device__ __forceinline__ void operator()(const f32x4 (&acc)[2][2][4][2], const Unit& u, int wr, int wc, int fr, int fq) const {
        const int row0 = u.pm * 256 + wr * 64 + fr, col0 = wc * 32 + 8 * fq; const int g = u.pn;
        EPI_FOR_ROWS() {
            const int gr = row0 + ai * 128 + m * 16, chunk = gr & 2047;
#pragma unroll
            for (int bj = 0; bj < 2; ++bj) { const int col = col0 + bj * 128, t = col >> 4, h0 = col & 15;
                const u32x4 uw = *(const u32x4*)(a2 + (size_t)gr * 384 + col); float uu[8]; UNPACK8(uw, uu);
                const f32x4 d0 = *(const f32x4*)(dsk + g * 16 + h0), d1 = *(const f32x4*)(dsk + g * 16 + h0 + 4); float o[8];
#pragma unroll
                for (int e = 0; e < 4; ++e) { o[e] = gelu_t(acc[ai][bj][m][0][e] + d0[e] * uu[e]); o[4 + e] = gelu_t(acc[ai][bj][m][1][e] + d1[e] * uu[4 + e]); }
                u32x4 w; w.x = cvt_pk_bf16(o[0], o[1]); w.y = cvt_pk_bf16(o[2], o[3]); w.z = cvt_pk_bf16(o[4], o[5]); w.w = cvt_pk_bf16(o[6], o[7]);
                *(u32x4*)(yg + ((size_t)chunk * 16 + t) * 512 + g * 16 + h0) = w; }
        }
    }
};
struct EpiGlu {
    const bf16_t* yg; bf16_t* mix; const float* gb;
    __device__ __forceinline__ void operator()(const f32x4 (&acc)[2][2][4][2], const Unit& u, int wr, int wc, int fr, int fq) const {
        EPI_ROWCOL();
        EPI_FOR_ROWS() {
            const int row = row0 + ai * 128 + m * 16;
#pragma unroll
            for (int bj = 0; bj < 2; ++bj) { const int col = col0 + bj * 128;
                const f32x4 b0 = *(const f32x4*)(gb + col), b1 = *(const f32x4*)(gb + col + 4);
                const u32x4 yw = *(const u32x4*)(yg + (size_t)row * 512 + col); float y[8]; UNPACK8(yw, y);
                const f32x4 a0 = acc[ai][bj][m][0] + b0, a1 = acc[ai][bj][m][1] + b1; float o[8];
#pragma unroll
                for (int e = 0; e < 4; ++e) { o[e] = y[e] * sigm(a0[e]); o[4 + e] = y[4 + e] * sigm(a1[e]); }
                u32x4 w; w.x = cvt_pk_bf16(o[0], o[1]); w.y = cvt_pk_bf16(o[2], o[3]); w.z = cvt_pk_bf16(o[4], o[5]); w.w = cvt_pk_bf16(o[6], o[7]);
                *(u32x4*)(mix + (size_t)row * 1024 + 512 + col) = w; }
        }
    }
};
struct EpiResid {
    bf16_t* xb; float* ssq;
    __device__ __forceinline__ void operator()(const f32x4 (&acc)[2][2][4][2], const Unit& u, int wr, int wc, int fr, int fq) const {
        EPI_ROWCOL();
        EPI_FOR_ROWS() {
            const int row = row0 + ai * 128 + m * 16; float ss = 0.f;
#pragma unroll
            for (int bj = 0; bj < 2; ++bj) { const int col = col0 + bj * 128; const size_t off = (size_t)row * 1024 + col;
                const u32x4 xw = *(const u32x4*)(xb + off); float xo[8]; UNPACK8(xw, xo);
                const f32x4 x0 = (f32x4){xo[0], xo[1], xo[2], xo[3]} + acc[ai][bj][m][0], x1 = (f32x4){xo[4], xo[5], xo[6], xo[7]} + acc[ai][bj][m][1];
                ss += (x0[0] * x0[0] + x0[1] * x0[1]) + (x0[2] * x0[2] + x0[3] * x0[3]) + (x1[0] * x1[0] + x1[1] * x1[1]) + (x1[2] * x1[2] + x1[3] * x1[3]);
                u32x4 w; w.x = cvt_pk_bf16(x0[0], x0[1]); w.y = cvt_pk_bf16(x0[2], x0[3]); w.z = cvt_pk_bf16(x1[0], x1[1]); w.w = cvt_pk_bf16(x1[2], x1[3]);
                *(u32x4*)(xb + off) = w; }
            ss += __shfl_xor(ss, 16); ss += __shfl_xor(ss, 32);
            if (fq == 0) ssq[(size_t)row * 16 + u.pn * 4 + wc] = ss;
        }
    }
};

__device__ __forceinline__ void cvt_matrix(const float* W, int K, int N, bf16_t* Wt, const float* gk, int upperm, LAS float* tile, int bid, int G, int tid) {
    const int nst = N / 256, ntiles = (K / 64) * nst;
    for (int ti = bid; ti < ntiles; ti += G) {
        const int kt = ti / nst, ns = ti % nst;
        { const int r = tid >> 3, cb = (tid & 7) * 8; const float s = gk ? gk[kt * 64 + r] : 1.0f;
#pragma unroll
          for (int q = 0; q < 4; ++q) { const int c = cb + 64 * q; const float* src = W + (size_t)(kt * 64 + r) * N + ns * 256 + c;
              const f32x4 v0 = *(const f32x4*)src, v1 = *(const f32x4*)(src + 4);
              LAS float* d = tile + r * 257 + c; d[0] = v0[0] * s; d[1] = v0[1] * s; d[2] = v0[2] * s; d[3] = v0[3] * s; d[4] = v1[0] * s; d[5] = v1[1] * s; d[6] = v1[2] * s; d[7] = v1[3] * s; } }
        __syncthreads();
        { const int n = tid >> 1, ks = (tid & 1) * 32; int nd = ns * 256 + n;
          if (upperm == 1) { nd = (nd < DFF) ? ((nd >> 7) * 256 + (nd & 127)) : (((nd - DFF) >> 7) * 256 + 128 + ((nd - DFF) & 127)); }
          if (upperm == 3) { const int ar = nd >> 9, ch = nd & 511, c64 = ch & 63, slot = (ar == 0) ? 0 : (ar == 2) ? 1 : (ar == 1) ? 2 : 3;
              nd = (ch >> 6) * 256 + 128 * (slot >> 1) + 32 * (c64 >> 4) + 8 * ((c64 >> 2) & 3) + 4 * (slot & 1) + (c64 & 3); }
          if (upperm == 2) { nd = (nd < 512) ? ((nd >> 7) * 256 + (nd & 127)) : (nd < 1024) ? (nd + 512) : (nd < 1536) ? (((nd - 1024) >> 7) * 256 + 128 + ((nd - 1024) & 127)) : nd; }
#pragma unroll
          for (int q = 0; q < 4; ++q) { const LAS float* sp = tile + (ks + 8 * q) * 257 + n;
              u32x4 w; w.x = cvt_pk_bf16(sp[0], sp[257]); w.y = cvt_pk_bf16(sp[514], sp[771]); w.z = cvt_pk_bf16(sp[1028], sp[1285]); w.w = cvt_pk_bf16(sp[1542], sp[1799]);
              *(u32x4*)(Wt + (size_t)nd * K + kt * 64 + ks + 8 * q) = w; } }
        __syncthreads();
    }
}
__device__ __forceinline__ void s5_setup(PCP p, int j, int g, int part, LAS float* lds, int tid) {
    LAS float* PW = lds;
    LAS float* BB = lds + 2176;
    LAS float* CC = BB + 2048;
    LAS float* KT = CC + 2048;
    const int jg = j * 32 + g;
    const double st = exp((double)p->in[4][jg]);
    for (int e = tid; e < 64 * 17; e += 512) { const int pp = e / 17, k = e % 17; const double are = p->in[5][jg * 64 + pp], aim = p->in[6][jg * 64 + pp];
        const double mag = exp(are * st * k), ang = aim * st * k; PW[e * 2] = (float)(mag * cos(ang)); PW[e * 2 + 1] = (float)(mag * sin(ang)); }
    for (int e = tid; e < 64 * 16; e += 512) { const int pp = e >> 4, h = e & 15; const double are = p->in[5][jg * 64 + pp], aim = p->in[6][jg * 64 + pp];
        const double mag = exp(are * st), ang = aim * st; const double nr = mag * cos(ang) - 1.0, ni = mag * sin(ang); const double den = are * are + aim * aim;
        const double qr = (nr * are + ni * aim) / den, qi = (ni * are - nr * aim) / den;
        const double br = p->in[7][((size_t)jg * 64 + pp) * 16 + h], bi = p->in[8][((size_t)jg * 64 + pp) * 16 + h];
        BB[e * 2] = (float)(qr * br - qi * bi); BB[e * 2 + 1] = (float)(qr * bi + qi * br); }
    for (int e = tid; e < 1024; e += 512) { CC[e * 2] = p->in[9][(size_t)jg * 1024 + e]; CC[e * 2 + 1] = p->in[10][(size_t)jg * 1024 + e]; }
    if (tid < 64 && part == 0) { const double are = p->in[5][jg * 64 + tid], aim = p->in[6][jg * 64 + tid]; float* lq = (float*)(p->ws + WS_LQ) + (size_t)j * 8192;
        { const double mag = exp(are * st * 16.0), ang = aim * st * 16.0; lq[(g * 64 + tid) * 2] = (float)(mag * cos(ang)); lq[(g * 64 + tid) * 2 + 1] = (float)(mag * sin(ang)); }
        { const double mag = exp(are * st * 512.0), ang = aim * st * 512.0; lq[4096 + (g * 64 + tid) * 2] = (float)(mag * cos(ang)); lq[4096 + (g * 64 + tid) * 2 + 1] = (float)(mag * sin(ang)); } }
    __syncthreads();
    for (int e = tid; e < 4096; e += 512) { const int tau = e >> 8, hp = (e >> 4) & 15, h = e & 15; float s = 0.f;
        for (int pp = 0; pp < 64; ++pp) { const float cr = CC[(hp * 64 + pp) * 2], ci = CC[(hp * 64 + pp) * 2 + 1], pr = PW[(pp * 17 + tau) * 2], pi = PW[(pp * 17 + tau) * 2 + 1];
            const float xr = cr * pr - ci * pi, xi = cr * pi + ci * pr; s += xr * BB[(pp * 16 + h) * 2] - xi * BB[(pp * 16 + h) * 2 + 1]; }
        KT[e] = s; }
    __syncthreads();
    bf16_t* mct = (bf16_t*)(p->ws + WS_MCT + (size_t)j * 6 * MiB) + (size_t)g * 256 * 384;
    for (int e = tid + part * 512; e < 256 * 384; e += 2048) { const int n = e / 384, k = e % 384, t = n >> 4, hp = n & 15; float v;
        if (k < 256) { const int s = k >> 4, h = k & 15; v = (s <= t) ? KT[((t - s) * 16 + hp) * 16 + h] : 0.f; }
        else { const int jj = k - 256, pp = jj & 63; const float cr = CC[(hp * 64 + pp) * 2], ci = CC[(hp * 64 + pp) * 2 + 1], pr = PW[(pp * 17 + t + 1) * 2], pi = PW[(pp * 17 + t + 1) * 2 + 1];
            v = (jj < 64) ? (cr * pr - ci * pi) : -(cr * pi + ci * pr); }
        mct[e] = f2bf(v); }
    bf16_t* bct = (bf16_t*)(p->ws + WS_BCT2 + (size_t)j * 4 * MiB) + (size_t)g * 256 * 256;
    for (int e = tid + part * 512; e < 128 * 256; e += 2048) bct[128 * 256 + e] = 0;
    for (int e = tid + part * 512; e < 128 * 256; e += 2048) { const int jj = e >> 8, k = e & 255, s = k >> 4, h = k & 15, pp = jj & 63;
        const float pr = PW[(pp * 17 + 15 - s) * 2], pi = PW[(pp * 17 + 15 - s) * 2 + 1], br = BB[(pp * 16 + h) * 2], bi = BB[(pp * 16 + h) * 2 + 1];
        bct[e] = f2bf((jj < 64) ? (pr * br - pi * bi) : (pr * bi + pi * br)); }
    __syncthreads();
}

__device__ __forceinline__ bf16_t* wl(PCP p, int i, size_t off) { return (bf16_t*)(p->ws + WS_W + (size_t)i * WL_STRIDE + off); }

__device__ __forceinline__ void phase0(PCP p, LAS unsigned char* lds, int bid, int G, int tid) {
    tid = opq(tid); p = opqp(p);
    LAS float* tile = (LAS float*)lds;
    const int wid = tid >> 6, lane = tid & 63;
    for (int i = 0; i < 4; ++i) {
        const int j = i >> 1;
        if ((i & 1) == 0) cvt_matrix(p->in[2] + (size_t)j * 1024 * 2048, 1024, 2048, wl(p, i, 0), p->in[1] + i * 1024, 3, tile, bid, G, tid);
        else              cvt_matrix(p->in[15] + (size_t)j * 1024 * 1536, 1024, 1536, wl(p, i, 0), p->in[1] + i * 1024, 0, tile, bid, G, tid);
        cvt_matrix(((i & 1) == 0 ? p->in[14] : p->in[21]) + (size_t)j * 1024 * 1024, 1024, 1024, wl(p, i, 4 * MiB), nullptr, 0, tile, bid, G, tid);
        cvt_matrix(p->in[23] + (size_t)i * 1024 * NUP, 1024, NUP, wl(p, i, 6 * MiB), p->in[22] + i * 1024, 1, tile, bid, G, tid);
        cvt_matrix(p->in[26] + (size_t)i * DFF * 1024, DFF, 1024, wl(p, i, 17 * MiB), nullptr, 0, tile, bid, G, tid);
    }
    for (int j = 0; j < 2; ++j) {
        cvt_matrix(p->in[12] + (size_t)j * 512 * 512, 512, 512, (bf16_t*)(p->ws + WS_GLU + (size_t)j * 512 * 1024), nullptr, 0, tile, bid, G, tid);
        { bf16_t* pwbd = (bf16_t*)(p->ws + WS_PWBD + (size_t)j * 512 * 1024); bf16_t* wsbd = (bf16_t*)(p->ws + WS_WSBD + (size_t)j * 512 * 1024);
          for (int e = bid * 512 + tid; e < 512 * 512; e += G * 512) { const int n = e >> 9, k = e & 511, gn = n >> 7, gk2 = k >> 7;
              pwbd[e] = f2bf(gn == gk2 ? p->in[16][(((size_t)j * 4 + gn) * 128 + (k & 127)) * 128 + (n & 127)] * p->in[17][j * 512 + n] : 0.f);
              wsbd[e] = f2bf((gn == gk2 && (k & 127) <= (n & 127)) ? p->in[19][(((size_t)j * 4 + gn) * 128 + (n & 127)) * 128 + (k & 127)] : 0.f); } }
    }
    for (int it = bid; it < 256; it += G) s5_setup(p, it >> 7, (it >> 2) & 31, it & 3, (LAS float*)lds, tid);
    { const float* x = p->in[0]; bf16_t* xb = (bf16_t*)(p->ws + WS_XB); float* ssq = (float*)(p->ws + WS_SSQ) + (size_t)16 * T;
      for (int row0 = (bid * 8 + wid) * 4; row0 < T; row0 += G * 8 * 4) { float ss[4]; f32x4 va[4][2], vb[4][2];
#pragma unroll
          for (int r = 0; r < 4; ++r)
#pragma unroll
              for (int h = 0; h < 2; ++h) { const float* xp = x + (size_t)(row0 + r) * 1024 + h * 512 + lane * 8; va[r][h] = *(const f32x4*)xp; vb[r][h] = *(const f32x4*)(xp + 4); }
#pragma unroll
          for (int r = 0; r < 4; ++r) { ss[r] = 0.f;
#pragma unroll
              for (int h = 0; h < 2; ++h) { const f32x4 a = va[r][h], b = vb[r][h];
                  ss[r] += (a[0] * a[0] + a[1] * a[1]) + (a[2] * a[2] + a[3] * a[3]) + (b[0] * b[0] + b[1] * b[1]) + (b[2] * b[2] + b[3] * b[3]);
                  u32x4 w; w.x = cvt_pk_bf16(a[0], a[1]); w.y = cvt_pk_bf16(a[2], a[3]); w.z = cvt_pk_bf16(b[0], b[1]); w.w = cvt_pk_bf16(b[2], b[3]);
                  *(u32x4*)(xb + (size_t)(row0 + r) * 1024 + h * 512 + lane * 8) = w; }
              ss[r] = wave_sum(ss[r]); if (lane < 16) ssq[(size_t)(row0 + r) * 16 + lane] = (lane == 0) ? ss[r] : 0.f; } } }
}

__device__ __forceinline__ void phase_evenfix(PCP p, int j, int bid, int G, int tid) {
    tid = opq(tid); p = opqp(p);
    const float* head = (const float*)(p->ws + WS_HEAD); const float* tail = (const float*)(p->ws + WS_TAIL); bf16_t* mix = (bf16_t*)(p->ws + WS_MIX); const float* cw = p->in[3] + (size_t)j * 3 * 512;
    for (int idx = bid * 512 + tid; idx < 128 * 2 * 128; idx += G * 512) {
        const int pm = idx >> 8, r = (idx >> 7) & 1, c = (idx & 127) * 4;
        if ((pm & 15) == 0) continue;
        const f32x4 q0 = *(const f32x4*)(head + (((size_t)pm * 2 + r) * 2 + 0) * 512 + c), ba = *(const f32x4*)(head + (((size_t)pm * 2 + r) * 2 + 1) * 512 + c);
        const f32x4 q1 = (r == 1) ? *(const f32x4*)(head + (((size_t)pm * 2 + 0) * 2 + 0) * 512 + c) : *(const f32x4*)(tail + ((size_t)(pm - 1) * 2 + 1) * 512 + c);
        const f32x4 q2 = (r == 1) ? *(const f32x4*)(tail + ((size_t)(pm - 1) * 2 + 1) * 512 + c) : *(const f32x4*)(tail + ((size_t)(pm - 1) * 2 + 0) * 512 + c);
        const f32x4 ya = ba * (*(const f32x4*)(cw + c) * q2 + *(const f32x4*)(cw + 512 + c) * q1 + *(const f32x4*)(cw + 1024 + c) * q0);
        u32x2 w; w.x = cvt_pk_bf16(ya[0], ya[1]); w.y = cvt_pk_bf16(ya[2], ya[3]);
        *(u32x2*)(mix + ((size_t)pm * 256 + r) * 1024 + c) = w;
    }
}
__device__ __forceinline__ void phase_s5(PCP p, int j, LAS float* lds, int bid, int G, int tid) {
    tid = opq(tid); p = opqp(p);
    const int wid = tid >> 6, lane = tid & 63;
    bf16_t* a2 = (bf16_t*)(p->ws + WS_A2); float* sloc = (float*)(p->ws + WS_SLOC); const float* lq = (const float*)(p->ws + WS_LQ) + (size_t)j * 8192;
    const bf16_t* bct = (const bf16_t*)(p->ws + WS_BCT + (size_t)j * 2 * MiB); const bf16_t* mct = (const bf16_t*)(p->ws + WS_MCT + (size_t)j * 6 * MiB); bf16_t* yg = (bf16_t*)(p->ws + WS_YG);
    for (int it = bid; it < 256; it += G) { const int b = it >> 5, g = it & 31;
        const size_t rowb = (size_t)g * 2048 + b * 256;
        { const float ar = lq[(g * 64 + lane) * 2], ai = lq[(g * 64 + lane) * 2 + 1], br = lq[4096 + (g * 64 + lane) * 2], bi = lq[4096 + (g * 64 + lane) * 2 + 1];
          const size_t row0 = rowb + wid * 32;
          float xr[32], xi[32];
#pragma unroll
          for (int c = 0; c < 32; ++c) { xr[c] = sloc[(row0 + c) * 128 + lane]; xi[c] = sloc[(row0 + c) * 128 + 64 + lane]; }
          float sr = 0.f, si = 0.f;
#pragma unroll
          for (int c = 0; c < 32; ++c) { const float nr = ar * sr - ai * si + xr[c], ni = ar * si + ai * sr + xi[c]; sr = nr; si = ni; }
          lds[(wid * 64 + lane) * 2] = sr; lds[(wid * 64 + lane) * 2 + 1] = si;
          __syncthreads();
          sr = 0.f; si = 0.f;
          for (int v = 0; v < wid; ++v) { const float er = lds[(v * 64 + lane) * 2], ei = lds[(v * 64 + lane) * 2 + 1]; const float nr = br * sr - bi * si + er, ni = br * si + bi * sr + ei; sr = nr; si = ni; }
#pragma unroll
          for (int c = 0; c < 32; ++c) { a2[(row0 + c) * 384 + 256 + lane] = f2bf(sr); a2[(row0 + c) * 384 + 320 + lane] = f2bf(si);
              const float nr = ar * sr - ai * si + xr[c], ni = ar * si + ai * sr + xi[c]; sr = nr; si = ni; } }
        __syncthreads();
    }
}
__device__ __forceinline__ void pool_chunk(PCP p, int chunk, int tid) {
    const bf16_t* proj = (const bf16_t*)(p->ws + WS_PROJ); bf16_t* pooled = (bf16_t*)(p->ws + WS_A2);
    { const int idx = chunk * 512 + tid;
        const int t0 = (idx >> 6) * 16, c = (idx & 63) * 8, pos0 = t0 & (SEQ - 1), w = 2 << (c >> 7);
        float s[8];
#pragma unroll
        for (int e = 0; e < 8; ++e) s[e] = 0.f;
#pragma unroll
        for (int k = 1; k < 16; ++k) { if (k < w && k <= pos0) { const u32x4 zw = *(const u32x4*)(proj + (size_t)(t0 - k) * 1536 + c); float q[8]; UNPACK8(zw, q);
#pragma unroll
            for (int e = 0; e < 8; ++e) s[e] += q[e]; } }
#pragma unroll
        for (int i = 0; i < 16; ++i) { const int t = t0 + i, pos = pos0 + i;
            const u32x4 zw = *(const u32x4*)(proj + (size_t)t * 1536 + c); float z[8]; UNPACK8(zw, z);
#pragma unroll
            for (int e = 0; e < 8; ++e) s[e] += z[e];
            const int cnt = (pos + 1 < w) ? pos + 1 : w; const float inv = 1.0f / (float)cnt;
            u32x4 o; o.x = cvt_pk_bf16(s[0] * inv - z[0], s[1] * inv - z[1]); o.y = cvt_pk_bf16(s[2] * inv - z[2], s[3] * inv - z[3]); o.z = cvt_pk_bf16(s[4] * inv - z[4], s[5] * inv - z[5]); o.w = cvt_pk_bf16(s[6] * inv - z[6], s[7] * inv - z[7]);
            *(u32x4*)(pooled + (size_t)t * 512 + c) = o;
            if (pos + 1 >= w) { const u32x4 ow = *(const u32x4*)(proj + (size_t)(t + 1 - w) * 1536 + c); float q[8]; UNPACK8(ow, q);
#pragma unroll
                for (int e = 0; e < 8; ++e) s[e] -= q[e]; } }
    }
}
__device__ __forceinline__ void sguprep_chunk(PCP p, int j, LAS unsigned char* lds, int it, int tid) {
    const int wid = tid >> 6, lane = tid & 63;
    const bf16_t* proj = (const bf16_t*)(p->ws + WS_PROJ); bf16_t* vt = (bf16_t*)(p->ws + WS_SLOC); const float* ng = p->in[18] + (size_t)j * 512;
    LAS float* rstd = (LAS float*)lds; LAS bf16_t* tl = (LAS bf16_t*)(lds + 1024);
    { const size_t T0 = (size_t)it * 128;
#pragma unroll
        for (int s0 = 0; s0 < 16; ++s0) { const int s = wid * 16 + s0; const u32x4 vw = *(const u32x4*)(proj + (T0 + s) * 1536 + 1024 + lane * 8); float v[8]; UNPACK8(vw, v); float ss = 0.f;
#pragma unroll
            for (int e = 0; e < 8; ++e) ss += v[e] * v[e];
            ss = wave_sum(ss); if (lane == 0) rstd[s] = rsqrtf(ss * (1.0f / 512.0f) + EPS); }
        __syncthreads();
        for (int h = 0; h < 4; ++h) {
            const int d0 = (tid & 15) * 8; const f32x4 g0 = *(const f32x4*)(ng + h * 128 + d0), g1 = *(const f32x4*)(ng + h * 128 + d0 + 4);
#pragma unroll
            for (int i = 0; i < 4; ++i) { const int s = (tid >> 4) + 32 * i; const u32x4 vw = *(const u32x4*)(proj + (T0 + s) * 1536 + 1024 + h * 128 + d0); float v[8]; UNPACK8(vw, v); const float rs = rstd[s];
#pragma unroll
                for (int e = 0; e < 4; ++e) { tl[(d0 + e) * 130 + s] = f2bf(v[e] * rs * g0[e]); tl[(d0 + 4 + e) * 130 + s] = f2bf(v[4 + e] * rs * g1[e]); } }
            __syncthreads();
#pragma unroll
            for (int i = 0; i < 4; ++i) { const int d = (tid >> 4) + 32 * i, s0 = (tid & 15) * 8; const LAS unsigned* src = (const LAS unsigned*)(tl + d * 130 + s0);
                u32x4 w; w.x = src[0]; w.y = src[1]; w.z = src[2]; w.w = src[3];
                *(u32x4*)(vt + ((size_t)it * 128 + d) * 512 + h * 128 + s0) = w; }
            __syncthreads();
        }
    }
}
__device__ __forceinline__ void phase_odd(PCP p, int j, LAS unsigned char* lds, int bid, int G, int tid) {
    tid = opq(tid); p = opqp(p);
    for (int it = bid; it < 256; it += G) {
        pool_chunk(p, it, tid);
        sguprep_chunk(p, j, lds, it, tid);
        __syncthreads();
    }
}
__device__ __forceinline__ void ffnfix_panel(PCP p, int i, int pm, int tid) {
    if ((pm & 15) == 0) return;
    const float* head = (const float*)(p->ws + WS_HEAD); const float* tail = (const float*)(p->ws + WS_TAIL); bf16_t* act = (bf16_t*)(p->ws + WS_ACT);
    const float* cw = p->in[24] + (size_t)i * 3 * NUP; const float* cb = p->in[25] + (size_t)i * NUP;
    for (int idx = tid; idx < 2 * 704; idx += 512) {
        const int r = idx / 704, c = (idx - r * 704) * 4;
        const float* h0 = head + ((size_t)pm * 2) * NUP; const float* t0 = tail + ((size_t)(pm - 1) * 2) * NUP;
        const float* r0 = (r == 1) ? h0 + NUP : h0;
        const float* r1 = (r == 1) ? h0 : t0 + NUP;
        const float* r2 = (r == 1) ? t0 + NUP : t0;
        const f32x4 g = *(const f32x4*)(cb + c) + *(const f32x4*)(cw + c) * *(const f32x4*)(r2 + c) + *(const f32x4*)(cw + NUP + c) * *(const f32x4*)(r1 + c) + *(const f32x4*)(cw + 2 * NUP + c) * *(const f32x4*)(r0 + c);
        const f32x4 v = *(const f32x4*)(cb + DFF + c) + *(const f32x4*)(cw + DFF + c) * *(const f32x4*)(r2 + DFF + c) + *(const f32x4*)(cw + NUP + DFF + c) * *(const f32x4*)(r1 + DFF + c) + *(const f32x4*)(cw + 2 * NUP + DFF + c) * *(const f32x4*)(r0 + DFF + c);
        u32x2 w; w.x = cvt_pk_bf16(g[0] * sigm(g[0]) * v[0], g[1] * sigm(g[1]) * v[1]); w.y = cvt_pk_bf16(g[2] * sigm(g[2]) * v[2], g[3] * sigm(g[3]) * v[3]);
        *(u32x2*)(act + ((size_t)pm * 256 + r) * DFF + c) = w;
    }
}
__device__ __forceinline__ void phase_final(PCP p, int bid, int G, int tid) {
    tid = opq(tid); p = opqp(p);
    const int wid = tid >> 6, lane = tid & 63; const float* ssq = (const float*)(p->ws + WS_SSQ) + (size_t)16 * T; const float* gf = p->in[27]; const bf16_t* xb = (const bf16_t*)(p->ws + WS_XB);
    for (int row = bid * 8 + wid; row < T; row += G * 8) { float sq = (lane < 16) ? ssq[(size_t)row * 16 + lane] : 0.f; sq = wave_sum(sq); const float rs = rsqrtf(sq * (1.0f / 1024.0f) + EPS);
#pragma unroll
        for (int q = 0; q < 2; ++q) { const int c = q * 512 + lane * 8; const u32x4 xw = *(const u32x4*)(xb + (size_t)row * 1024 + c); float x[8]; UNPACK8(xw, x);
            const f32x4 g0 = *(const f32x4*)(gf + c), g1 = *(const f32x4*)(gf + c + 4);
            *(f32x4*)(p->out + (size_t)row * 1024 + c) = (f32x4){x[0], x[1], x[2], x[3]} * rs * g0; *(f32x4*)(p->out + (size_t)row * 1024 + c + 4) = (f32x4){x[4], x[5], x[6], x[7]} * rs * g1; } }
}

#define GSYNC() xcd_barrier(xbar)
__global__ void __launch_bounds__(512, 2) mega(P parg) {
    extern __shared__ __attribute__((aligned(16))) unsigned char lds_raw[];
    LAS unsigned char* lds = (LAS unsigned char*)lds_raw;
    PCP p = (PCP)__builtin_amdgcn_kernarg_segment_ptr();
    if (parg.ws == nullptr) cg::this_grid().sync();
    const int tid = threadIdx.x, bid = blockIdx.x, G = gridDim.x;
    unsigned char* ws = p->ws;
    float* ssq0 = (float*)(ws + WS_SSQ); float* ssq1 = ssq0 + (size_t)16 * T;
    bf16_t* xb = (bf16_t*)(ws + WS_XB); bf16_t* proj = (bf16_t*)(ws + WS_PROJ); bf16_t* mix = (bf16_t*)(ws + WS_MIX); bf16_t* a2 = (bf16_t*)(ws + WS_A2); bf16_t* yg = (bf16_t*)(ws + WS_YG);
    bf16_t* act = (bf16_t*)(ws + WS_ACT);

    if (tid < 4) ((LAS unsigned*)(lds + LDS_BARW))[tid] = 0u;
    __syncthreads();
    XcdBarrier xbar = xcd_barrier_post((unsigned*)(ws + WS_BAR), (volatile LAS unsigned*)(lds + LDS_BARW));
    phase0(p, lds, bid, G, tid);
    GSYNC();
    for (int i = 0; i < 4; ++i) {
        const int j = i >> 1;
        if ((i & 1) == 0) {
            { pg8::Gemm g{xb, wl(p, i, 0), T, 2048, 1024, 1024, 1024}; pg8::StaticOrder S; S.init(T, 2048, G, bid); EpiProjEven4 E{mix, a2, ssq1, p->in[3] + (size_t)j * 3 * 512, (float*)(ws + WS_HEAD), (float*)(ws + WS_TAIL), (LAS float*)(lds + LDS_HALO)}; pg8::gemm_phase(lds, g, S, E);
            }
            GSYNC();
            { int k256 = 256; asm volatile("" : "+s"(k256));
              pg8::Gemm g{a2, (const bf16_t*)(ws + WS_BCT2 + (size_t)j * 4 * MiB), 65536, 8192, k256, 384, 256}; pg8::StaticOrder S; S.init_diag(256, G, bid); EpiS5a E{(float*)(ws + WS_SLOC)}; pg8::gemm_phase(lds, g, S, E); }
            GSYNC();
            phase_evenfix(p, j, bid, G, tid); phase_s5(p, j, (LAS float*)lds, bid, G, tid);
            GSYNC();
            { int k384 = 384; asm volatile("" : "+s"(k384));
              pg8::Gemm g{a2, (const bf16_t*)(ws + WS_MCT + (size_t)j * 6 * MiB), 65536, 8192, k384, 384, 384}; pg8::StaticOrder S; S.init_diag(256, G, bid); EpiS5c E{a2, p->in[11] + (size_t)j * 512, yg}; pg8::gemm_phase(lds, g, S, E); }
            GSYNC();
            { pg8::Gemm g{yg, (const bf16_t*)(ws + WS_GLU + (size_t)j * 512 * 1024), T, 512, 512, 512, 512}; pg8::StaticOrder S; S.init(T, 512, G, bid); EpiGlu E{yg, mix, p->in[13] + (size_t)j * 512}; pg8::gemm_phase(lds, g, S, E);
            }
            GSYNC();
        } else {
            { pg8::Gemm g{xb, wl(p, i, 0), T, 1536, 1024, 1024, 1024}; pg8::StaticOrder S; S.init(T, 1536, G, bid); EpiProjOdd E{proj, ssq1}; pg8::gemm_phase(lds, g, S, E);
            }
            GSYNC();
            phase_odd(p, j, lds, bid, G, tid);
            GSYNC();
            { int k512 = 512; asm volatile("" : "+s"(k512));
              { pg8::Gemm g{(const bf16_t*)(ws + WS_A2), (const bf16_t*)(ws + WS_PWBD + (size_t)j * 512 * 1024), T, 512, k512, 512, 512}; pg8::StaticOrder S; S.init(T, 512, G, bid); EpiPoolOut E{mix}; pg8::gemm_phase(lds, g, S, E); }
              { pg8::Gemm g{(const bf16_t*)(ws + WS_WSBD + (size_t)j * 512 * 1024), (const bf16_t*)(ws + WS_SLOC), 512, T, k512, 512, 512}; pg8::StaticOrder S; S.init(512, T, G, bid); EpiSguOut E{proj, p->in[20] + (size_t)j * 512, mix}; pg8::gemm_phase(lds, g, S, E); } }
            GSYNC();
        }
        { pg8::Gemm g{mix, wl(p, i, 4 * MiB), T, 1024, 1024, 1024, 1024}; pg8::StaticOrder S; S.init(T, 1024, G, bid);
          EpiResid E{xb, ssq0}; pg8::gemm_phase(lds, g, S, E);
        }
        GSYNC();
        { pg8::Gemm g{xb, wl(p, i, 6 * MiB), T, NUP, 1024, 1024, 1024}; pg8::StaticOrder S; S.init(T, NUP, G, bid);
          EpiUpFused E{act, ssq0, p->in[24] + (size_t)i * 3 * NUP, p->in[25] + (size_t)i * NUP, (float*)(ws + WS_HEAD), (float*)(ws + WS_TAIL), (LAS float*)(lds + LDS_HALO)}; pg8::gemm_phase(lds, g, S, E);
        }
        GSYNC();
        { pg8::Gemm g{act, wl(p, i, 17 * MiB), T, 1024, DFF, DFF, DFF}; pg8::StaticOrder S; S.init(T, 1024, G, bid); EpiResid E{xb, ssq1};
          { const int t2 = opq(tid); Unit fu; for (int ui = 0; S.next(ui, fu); ++ui) ffnfix_panel(p, i, fu.pm, t2); asm volatile("s_waitcnt vmcnt(0)" ::: "memory"); __syncthreads(); }
          pg8::gemm_phase(lds, g, S, E);
        }
        GSYNC();
    }
    phase_final(p, bid, G, tid);
}

extern "C" void kernel_launch(void* const* d_in, const int* in_sizes, int n_in, void* d_out, int out_size, void* d_ws, size_t ws_size, hipStream_t stream) {
    static int grid = 0;
    if (grid == 0) {
        if (n_in != 28 || out_size != T * D || ws_size < WS_END) { fprintf(stderr, "kernel_launch: unexpected shapes (n_in %d, out %d, ws %zu < %zu)\n", n_in, out_size, ws_size, (size_t)WS_END); }
        int dev = 0, cus = 0, per_cu = 0;
        hipGetDevice(&dev); hipDeviceGetAttribute(&cus, hipDeviceAttributeMultiprocessorCount, dev);
        hipFuncSetAttribute((const void*)mega, hipFuncAttributeMaxDynamicSharedMemorySize, LDS_BYTES);
        hipOccupancyMaxActiveBlocksPerMultiprocessor(&per_cu, (const void*)mega, 512, LDS_BYTES);
        (void)hipGetLastError();
        grid = cus > 0 ? cus : 256;
        if (per_cu < 1) fprintf(stderr, "kernel_launch: occupancy query reports %d blocks per CU\n", per_cu);
    }
    (void)hipMemsetAsync((char*)d_ws + WS_BAR, 0, 16384, stream);
    P p{};
    for (int i = 0; i < 28; ++i) p.in[i] = (const float*)d_in[i];
    p.out = (float*)d_out; p.ws = (unsigned char*)d_ws;
    void* args[] = {&p};
    hipError_t e = hipLaunchCooperativeKernel((const void*)mega, dim3(grid), dim3(512), args, LDS_BYTES, stream);
    if (e != hipSuccess) fprintf(stderr, "cooperative launch failed: %s (grid %d)\n", hipGetErrorString(e), grid);
}
```

```cpp
#include <hip/hip_runtime.h>
#include <hip/hip_cooperative_groups.h>
#include <cstdio>
namespace cg = cooperative_groups;

#define LAS __attribute__((address_space(3)))
typedef unsigned short bf16_t;
typedef short bf16x8 __attribute__((ext_vector_type(8)));
typedef float f32x4 __attribute__((ext_vector_type(4)));
typedef unsigned u32x4 __attribute__((ext_vector_type(4)));
typedef unsigned u32x2 __attribute__((ext_vector_type(2)));

constexpr int T = 32768, D = 1024, SEQ = 4096, DFF = 2816, NUP = 5632, TH = 16384;
constexpr float EPS = 1e-6f;
constexpr size_t MiB = 1ull << 20;
constexpr size_t WS_SSQ = 450 * MiB;
constexpr size_t WS_LQ = 2 * MiB;
constexpr size_t WS_W = 4 * MiB;
constexpr size_t WL_STRIDE = 23 * MiB;
constexpr size_t WS_GLU = 96 * MiB;
constexpr size_t WS_POOLW = 97 * MiB;
constexpr size_t WS_SGUW = 97 * MiB + 512 * 1024;
constexpr size_t WS_BCT = 98 * MiB;
constexpr size_t WS_MCT = 102 * MiB;
constexpr size_t WS_XB = 114 * MiB;
constexpr size_t WS_R = 178 * MiB;
constexpr size_t WS_PROJ = WS_R;
constexpr size_t WS_MIX = WS_R + 96 * MiB;
constexpr size_t WS_A2 = WS_R + 160 * MiB;
constexpr size_t WS_SLOC = WS_R + 208 * MiB;
constexpr size_t WS_YG = WS_R + 240 * MiB;
constexpr size_t WS_ACT = WS_R;
constexpr size_t WS_HEAD = 454 * MiB;
constexpr size_t WS_TAIL = 460 * MiB;
constexpr size_t WS_BAR = 3 * MiB;
constexpr size_t WS_BCT2 = 466 * MiB;
constexpr size_t WS_PWBD = 474 * MiB;
constexpr size_t WS_WSBD = 475 * MiB;
constexpr size_t WS_END = 476 * MiB;
constexpr int LDS_STAGE = 131072, LDS_BARW = LDS_STAGE, LDS_HALO = LDS_STAGE + 64, LDS_BYTES = LDS_STAGE + 64 + 8192 + 1024 + 4096;

struct P { const float* in[28]; float* out; unsigned char* ws; };
typedef const __attribute__((address_space(4))) P* PCP;

__device__ __forceinline__ unsigned cvt_pk_bf16(float lo, float hi) { unsigned r; asm volatile("v_cvt_pk_bf16_f32 %0, %1, %2" : "=v"(r) : "v"(lo), "v"(hi)); return r; }
__device__ __forceinline__ bf16_t f2bf(float f) { unsigned u = __float_as_uint(f); u += 0x7FFFu + ((u >> 16) & 1u); return (bf16_t)(u >> 16); }
__device__ __forceinline__ float bflo(unsigned w) { return __uint_as_float(w << 16); }
__device__ __forceinline__ float bfhi(unsigned w) { return __uint_as_float(w & 0xffff0000u); }
__device__ __forceinline__ float sigm(float x) { return __builtin_amdgcn_rcpf(1.0f + __expf(-x)); }
__device__ __forceinline__ float gelu_t(float x) { const float z = 1.5957691216f * (x + 0.044715f * x * x * x); return x * sigm(z); }
__device__ __forceinline__ PCP opqp(PCP q) { asm volatile("" : "+s"(q)); return q; }
__device__ __forceinline__ int opq(int v) { asm volatile("" : "+v"(v)); return v; }
__device__ __forceinline__ float wave_sum(float v) {
#pragma unroll
    for (int o = 32; o >= 1; o >>= 1) v += __shfl_xor(v, o);
    return v;
}
__device__ __forceinline__ void UNPACK8(const u32x4 q, float (&f)[8]) { f[0] = bflo(q.x); f[1] = bfhi(q.x); f[2] = bflo(q.y); f[3] = bfhi(q.y); f[4] = bflo(q.z); f[5] = bfhi(q.z); f[6] = bflo(q.w); f[7] = bfhi(q.w); }


#define XB_TMO      128
#define XB_XCNT(j)  (256  + 64 * (j))
#define XB_XSUB(j)  (1280 + 64 * (j))
#define XB_XGEN(j)  (2304 + 64 * (j))
#define XB_TOP      3328
#define XB_TOPGEN   3392
#define XCD_BAR_WORDS 3456
#define XB_SPIN_CAP (1u << 20)
__device__ __forceinline__ unsigned xb_ld(unsigned* p)              { return __hip_atomic_load(p, __ATOMIC_RELAXED, __HIP_MEMORY_SCOPE_AGENT); }
__device__ __forceinline__ unsigned xb_add(unsigned* p, unsigned v) { return __hip_atomic_fetch_add(p, v, __ATOMIC_RELAXED, __HIP_MEMORY_SCOPE_AGENT); }
__device__ __forceinline__ unsigned xb_xcc_id() { return (unsigned)__builtin_amdgcn_s_getreg((3 << 11) | 20) & 0xFu; }
#define XB_SPIN(cond, bar) do { unsigned _sp = 0; while (cond) { __builtin_amdgcn_s_sleep(1); \
    if ((++_sp & 255u) == 0u) { if (xb_ld(&(bar)[XB_TMO])) break; if (_sp > XB_SPIN_CAP) { atomicAdd(&(bar)[XB_TMO], 1u); break; } } } } while (0)
struct XcdBarrier { unsigned* bar; unsigned x; volatile LAS unsigned* st; };
__device__ __forceinline__ XcdBarrier xcd_barrier_post(unsigned* bar, volatile LAS unsigned* st) {
    XcdBarrier b; b.bar = bar; b.x = 0u; b.st = st;
    if (threadIdx.x == 0) { const unsigned x = xb_xcc_id(); st[2] = x; (void)xb_add(&bar[XB_XCNT(x)], 1u); }
    return b;
}
__device__ __forceinline__ void xcd_barrier_complete(unsigned* bar, unsigned x, unsigned& nloc, unsigned& nx) {
    const unsigned G = gridDim.x * gridDim.y * gridDim.z;
    unsigned sum, cnt, mine, sp = 0u;
    for (;;) {
        sum = 0u; cnt = 0u; mine = 0u;
#pragma unroll
        for (unsigned j = 0; j < 16; ++j) { const unsigned c = xb_ld(&bar[XB_XCNT(j)]); sum += c; cnt += (c > 0u) ? 1u : 0u; mine = (j == x) ? c : mine; }
        if (sum == G) break;
        __builtin_amdgcn_s_sleep(1);
        if ((++sp & 255u) == 0u) { if (xb_ld(&bar[XB_TMO])) break; if (sp > XB_SPIN_CAP) { atomicAdd(&bar[XB_TMO], 1u); break; } }
    }
    nloc = mine > 0u ? mine : 1u; nx = cnt > 0u ? cnt : 1u;
}
__device__ __forceinline__ void xcd_barrier(const XcdBarrier& b) {
    asm volatile("s_waitcnt vmcnt(0) lgkmcnt(0)" ::: "memory");
    __syncthreads();
    if (threadIdx.x == 0) {
        unsigned* bar = b.bar;
        __builtin_amdgcn_s_waitcnt(0);
        unsigned nloc = b.st[0], nx = b.st[1]; const unsigned bx = b.st[2];
        if (nloc == 0u) { xcd_barrier_complete(bar, bx, nloc, nx); b.st[0] = nloc; b.st[1] = nx; }
        const unsigned old = xb_add(&bar[XB_XSUB(bx)], 1u);
        const unsigned gen = old / nloc;
        if (old + 1u == (gen + 1u) * nloc) {
            __builtin_amdgcn_fence(__ATOMIC_RELEASE, "agent");
            asm volatile("s_waitcnt vmcnt(0)" ::: "memory");
            const unsigned og = xb_add(&bar[XB_TOP], 1u);
            const unsigned tg = og / nx;
            if (og + 1u == (tg + 1u) * nx) xb_add(&bar[XB_TOPGEN], 1u);
            else XB_SPIN(xb_ld(&bar[XB_TOPGEN]) == tg, bar);
            __builtin_amdgcn_fence(__ATOMIC_ACQUIRE, "agent");
            xb_add(&bar[XB_XGEN(bx)], 1u);
            asm volatile("s_waitcnt vmcnt(0)" ::: "memory");
        } else {
            XB_SPIN(xb_ld(&bar[XB_XGEN(bx)]) == gen, bar);
            __builtin_amdgcn_fence(__ATOMIC_ACQUIRE, "agent");
            asm volatile("s_waitcnt vmcnt(0)" ::: "memory");
        }
    }
    __syncthreads();
}

namespace pg8 {
constexpr int BM = 256, BK = 64, HALF = 128, HTB = HALF * BK * 2, STAGE_BYTES = 8 * HTB, NXCD = 8, WGM = 8;
__device__ __forceinline__ int lds_byte(int r, int c) { const int st = (r >> 4) * 2 + (c >> 5), rr = r & 15, cc = c & 31, ob = rr * 64 + cc * 2; return st * 1024 + (ob ^ (((ob >> 9) & 1) << 5)); }
__device__ __forceinline__ void stage_rc(int b, int& R, int& C) { const int st = b / 1024, sb = b % 1024, swz = sb ^ (((sb >> 9) & 1) << 5); R = (st >> 1) * 16 + swz / 64; C = (st & 1) * 32 + (swz % 64) / 2; }
__device__ __forceinline__ int perm32(int rho) { const int n = rho >> 4, i = rho & 15; return 8 * (i >> 2) + 4 * n + (i & 3); }

struct Unit { int pm, pn; };
struct Gemm { const bf16_t* A; const bf16_t* Bt; int M, N, K, lda, ldb; };

struct StaticOrder {
    int nM, nN, nwg, G, c, diag;
    __device__ void init(int M, int N, int G_, int c_) { nM = M / BM; nN = N / BM; nwg = nM * nN; G = G_; c = c_; diag = 0; }
    __device__ void init_diag(int nunits, int G_, int c_) { nM = nunits; nN = 1; nwg = nunits; G = G_; c = c_; diag = 1; }
    __device__ bool next(int i, Unit& u) const {
        const long L = (long)i * G + c; if (L >= nwg) return false;
        if (diag) { u.pm = (int)L; u.pn = (int)(L >> 3); return true; }
        int wgid = (int)L; { const int q = nwg / NXCD, r = nwg % NXCD, xcd = wgid % NXCD, off = wgid / NXCD; wgid = (xcd < r ? xcd * (q + 1) : r * (q + 1) + (xcd - r) * q) + off; }
        const int nig = WGM * nN, gid = wgid / nig, fm = gid * WGM, gsz = (nM - fm) < WGM ? (nM - fm) : WGM;
        u.pm = fm + ((wgid % nig) % gsz); u.pn = (wgid % nig) / gsz; return true;
    }
};

template <class Epi>
__device__ __forceinline__ void gemm_phase(LAS unsigned char* lds, const Gemm g, const StaticOrder& S, const Epi& E) {
    const int tid = opq(threadIdx.x), wid = __builtin_amdgcn_readfirstlane(tid >> 6), lane = tid & 63, wr = wid >> 2, wc = wid & 3, fr = lane & 15, fq = lane >> 4;
    const int K = g.K, nt = K / BK;
    unsigned voffA[2], voffB[2];
#pragma unroll
    for (int i = 0; i < 2; ++i) { int R, C; stage_rc(tid * 16 + i * 8192, R, C); const int Rb = (R & ~31) + perm32(R & 31);
        voffA[i] = (unsigned)(R * g.lda + C) * 2u; voffB[i] = (unsigned)(Rb * g.ldb + C) * 2u; }
    const size_t kstep = (size_t)(BK * 2);
    const size_t hstepA = (size_t)HALF * g.lda * 2, hstepB = (size_t)HALF * g.ldb * 2;
    const size_t tstepA = 2 * hstepA, tstepB = 2 * hstepB;
    const unsigned ldsw = (unsigned)wid * 1024u, ldsu = (unsigned)(unsigned long)lds;
    const int aoff = lds_byte(wr * 64 + fr, fq * 8), boff = lds_byte(wc * 32 + fr, fq * 8);
#define PG8_SA(b, h) (((b) * 2 + (h)) * HTB)
#define PG8_SB(b, h) ((4 + (b) * 2 + (h)) * HTB)
#define PG8_STAGE(bufoff, gbase, voff) do { _Pragma("unroll") for (int _i = 0; _i < 2; ++_i) { \
        const unsigned _m0 = ldsu + (unsigned)(bufoff) + ldsw + (unsigned)(_i * 8192); \
        asm volatile("s_mov_b32 m0, %2\n\ts_nop 0\n\tglobal_load_lds_dwordx4 %0, %1" :: "v"((voff)[_i]), "s"((const char*)(gbase)), "s"(_m0) : "memory"); } } while (0)
#define PG8_LDA(dst, b, h) do { _Pragma("unroll") for (int m = 0; m < 4; ++m) _Pragma("unroll") for (int k = 0; k < 2; ++k) dst[m][k] = *(const LAS bf16x8*)(lds + PG8_SA(b, h) + aoff + m * 2048 + k * 1024); } while (0)
#define PG8_LDB(dst, b, h) do { _Pragma("unroll") for (int n = 0; n < 2; ++n) _Pragma("unroll") for (int k = 0; k < 2; ++k) dst[n][k] = *(const LAS bf16x8*)(lds + PG8_SB(b, h) + boff + n * 2048 + k * 1024); } while (0)
#define PG8_MMA(ai, bj, At, Bt) do { __builtin_amdgcn_s_setprio(1); _Pragma("unroll") for (int m = 0; m < 4; ++m) _Pragma("unroll") for (int n = 0; n < 2; ++n) _Pragma("unroll") for (int k = 0; k < 2; ++k) \
        acc[ai][bj][m][n] = __builtin_amdgcn_mfma_f32_16x16x32_bf16(Bt[n][k], At[m][k], acc[ai][bj][m][n], 0, 0, 0); __builtin_amdgcn_s_setprio(0); } while (0)
#define PG8_WAIT_V(n) asm volatile("s_waitcnt vmcnt(" #n ")" ::: "memory")
#define PG8_WAIT_L(n) asm volatile("s_waitcnt lgkmcnt(" #n ")" ::: "memory")
#define PG8_BAR __builtin_amdgcn_s_barrier()
#define PG8_SCHED __builtin_amdgcn_sched_barrier(0)
    Unit cur, nxt; int ui = 0;
    if (!S.next(0, cur)) return;
    f32x4 acc[2][2][4][2];
#pragma unroll
    for (int a = 0; a < 2; ++a)
#pragma unroll
        for (int b = 0; b < 2; ++b)
#pragma unroll
            for (int m = 0; m < 4; ++m)
#pragma unroll
                for (int n = 0; n < 2; ++n) acc[a][b][m][n] = (f32x4){0.f, 0.f, 0.f, 0.f};
    bf16x8 At[4][2], B0[2][2], B1[2][2];
    const char* cA = (const char*)g.A + (size_t)cur.pm * tstepA; const char* cB = (const char*)g.Bt + (size_t)cur.pn * tstepB;
    PG8_STAGE(PG8_SB(0, 0), cB, voffB); PG8_STAGE(PG8_SB(0, 1), cB + hstepB, voffB); PG8_STAGE(PG8_SA(0, 0), cA, voffA); PG8_STAGE(PG8_SA(0, 1), cA + hstepA, voffA);
    if (wr == 1) PG8_BAR;
    PG8_WAIT_V(2); PG8_BAR;
    PG8_STAGE(PG8_SB(1, 0), cB + kstep, voffB); PG8_STAGE(PG8_SA(1, 0), cA + kstep, voffA); PG8_STAGE(PG8_SB(1, 1), cB + hstepB + kstep, voffB);
    PG8_WAIT_V(6); PG8_BAR;
    for (;;) {
        const bool has_next = S.next(ui + 1, nxt);
        const char* nA = has_next ? (const char*)g.A + (size_t)nxt.pm * tstepA : cA; const char* nB = has_next ? (const char*)g.Bt + (size_t)nxt.pn * tstepB : cB;
        for (int t = 0; t < nt; t += 2) {
            const bool last = (t == nt - 2);
            const char* a1 = cA + (size_t)(t + 1) * kstep;
            const char* a2 = last ? nA : cA + (size_t)(t + 2) * kstep; const char* b2 = last ? nB : cB + (size_t)(t + 2) * kstep;
            const char* a3 = a2 + kstep; const char* b3 = b2 + kstep;
            PG8_LDB(B0, 0, 0); PG8_LDB(B1, 0, 1); PG8_SCHED; PG8_LDA(At, 0, 0); PG8_STAGE(PG8_SA(1, 1), a1 + hstepA, voffA);
            PG8_WAIT_V(8); PG8_WAIT_L(0); PG8_BAR; PG8_MMA(0, 0, At, B0); PG8_MMA(0, 1, At, B1); PG8_BAR; PG8_SCHED;
            PG8_LDA(At, 0, 1); PG8_STAGE(PG8_SB(0, 0), b2, voffB); PG8_STAGE(PG8_SB(0, 1), b2 + hstepB, voffB); PG8_STAGE(PG8_SA(0, 0), a2, voffA);
            PG8_WAIT_V(8); PG8_WAIT_L(0); PG8_BAR; PG8_MMA(1, 0, At, B0); PG8_MMA(1, 1, At, B1); PG8_BAR; PG8_SCHED;
            PG8_LDB(B0, 1, 0); PG8_LDB(B1, 1, 1); PG8_SCHED; PG8_LDA(At, 1, 0); PG8_STAGE(PG8_SA(0, 1), a2 + hstepA, voffA);
            PG8_WAIT_V(8); PG8_WAIT_L(0); PG8_BAR; PG8_MMA(0, 0, At, B0); PG8_MMA(0, 1, At, B1); PG8_BAR; PG8_SCHED;
            PG8_LDA(At, 1, 1); PG8_STAGE(PG8_SB(1, 0), b3, voffB); PG8_STAGE(PG8_SB(1, 1), b3 + hstepB, voffB); PG8_STAGE(PG8_SA(1, 0), a3, voffA);
            PG8_WAIT_V(8); PG8_WAIT_L(0); PG8_BAR; PG8_MMA(1, 0, At, B0); PG8_MMA(1, 1, At, B1); PG8_BAR; PG8_SCHED;
        }
        if (wr == 0) PG8_BAR;
        E(acc, cur, wr, wc, fr, fq);
        if (!has_next) break;
#pragma unroll
        for (int a = 0; a < 2; ++a)
#pragma unroll
            for (int b = 0; b < 2; ++b)
#pragma unroll
                for (int m = 0; m < 4; ++m)
#pragma unroll
                    for (int n = 0; n < 2; ++n) acc[a][b][m][n] = (f32x4){0.f, 0.f, 0.f, 0.f};
        cur = nxt; cA = nA; cB = nB; ++ui;
        if (wr == 1) PG8_BAR;
    }
    PG8_WAIT_V(0);
    PG8_BAR;
#undef PG8_SA
#undef PG8_SB
#undef PG8_STAGE
#undef PG8_LDA
#undef PG8_LDB
#undef PG8_MMA
#undef PG8_WAIT_V
#undef PG8_WAIT_L
#undef PG8_BAR
#undef PG8_SCHED
}
}
using pg8::Unit;

__device__ __forceinline__ float row_rstd(const float* ssq, int row, int fq) {
    const f32x4 q = *(const f32x4*)(ssq + (size_t)row * 16 + 4 * fq); float s = (q[0] + q[1]) + (q[2] + q[3]);
    s += __shfl_xor(s, 16); s += __shfl_xor(s, 32); return rsqrtf(s * (1.0f / 1024.0f) + EPS);
}
#define EPI_ROWCOL() const int row0 = u.pm * 256 + wr * 64 + fr, col0 = u.pn * 256 + wc * 32 + 8 * fq
#define EPI_FOR_ROWS() _Pragma("unroll") for (int ai = 0; ai < 2; ++ai) _Pragma("unroll") for (int m = 0; m < 4; ++m)

struct EpiProjOdd {
    bf16_t* proj; const float* ssq;
    __device__ __forceinline__ void operator()(const f32x4 (&acc)[2][2][4][2], const Unit& u, int wr, int wc, int fr, int fq) const {
        EPI_ROWCOL();
        EPI_FOR_ROWS() {
            const int row = row0 + ai * 128 + m * 16; const float rs = row_rstd(ssq, row, fq);
#pragma unroll
            for (int bj = 0; bj < 2; ++bj) { const int col = col0 + bj * 128; f32x4 v0 = acc[ai][bj][m][0] * rs, v1 = acc[ai][bj][m][1] * rs;
                if (u.pn >= 2) {
#pragma unroll
                    for (int e = 0; e < 4; ++e) { v0[e] = gelu_t(v0[e]); v1[e] = gelu_t(v1[e]); } }
                u32x4 w; w.x = cvt_pk_bf16(v0[0], v0[1]); w.y = cvt_pk_bf16(v0[2], v0[3]); w.z = cvt_pk_bf16(v1[0], v1[1]); w.w = cvt_pk_bf16(v1[2], v1[3]);
                *(u32x4*)(proj + (size_t)row * 1536 + col) = w; }
        }
    }
};
__device__ __forceinline__ f32x4 ror4(const f32x4 v, const int which) {
    f32x4 r;
#pragma unroll
    for (int e = 0; e < 4; ++e) { const int x = __float_as_int(v[e]); r[e] = __int_as_float(which == 1 ? __builtin_amdgcn_update_dpp(x, x, 0x121, 0xf, 0xf, false) : __builtin_amdgcn_update_dpp(x, x, 0x122, 0xf, 0xf, false)); }
    return r;
}
struct EpiProjEven4 {
    bf16_t* mix; bf16_t* a2; const float* ssq; const float* cw; float* head; float* tail; LAS float* hl;
    __device__ __forceinline__ void operator()(f32x4 (&acc)[2][2][4][2], const Unit& u, int wr, int wc, int fr, int fq) const {
        fr = opq(fr); fq = opq(fq);
        const int row0 = u.pm * 256 + wr * 64 + fr, ch = u.pn * 64 + wc * 16 + fq * 4;
        EPI_FOR_ROWS() { const int row = row0 + ai * 128 + m * 16; const float rs = row_rstd(ssq, row, fq);
            acc[ai][0][m][0] = (acc[ai][0][m][0] * rs) * (acc[ai][0][m][1] * rs); acc[ai][1][m][0] *= rs;
            const f32x4 uu = acc[ai][1][m][1] * rs; u32x2 w; w.x = cvt_pk_bf16(uu[0], uu[1]); w.y = cvt_pk_bf16(uu[2], uu[3]);
            *(u32x2*)(a2 + ((size_t)(ch >> 4) * 2048 + (row >> 4)) * 384 + (row & 15) * 16 + (ch & 15)) = w; }
        if (fr >= 14) {
#pragma unroll
            for (int ai = 0; ai < 2; ++ai) *(LAS f32x4*)(hl + ((((ai * 2 + wr) * 4 + wc) * 2 + (fr - 14)) * 16 + fq * 4)) = acc[ai][0][3][0];
            if (wr == 1) *(f32x4*)(tail + ((size_t)u.pm * 2 + (fr - 14)) * 512 + ch) = acc[1][0][3][0]; }
        if (wr == 0 && fr < 2) { *(f32x4*)(head + (((size_t)u.pm * 2 + fr) * 2 + 0) * 512 + ch) = acc[0][0][0][0]; *(f32x4*)(head + (((size_t)u.pm * 2 + fr) * 2 + 1) * 512 + ch) = acc[0][1][0][0]; }
        asm volatile("s_waitcnt lgkmcnt(0)" ::: "memory"); __builtin_amdgcn_s_barrier(); asm volatile("" ::: "memory");
        const f32x4 w0 = *(const f32x4*)(cw + ch), w1 = *(const f32x4*)(cw + 512 + ch), w2 = *(const f32x4*)(cw + 1024 + ch);
        const bool seq0 = (u.pm & 15) == 0;
#pragma unroll
        for (int ai = 0; ai < 2; ++ai)
#pragma unroll
            for (int m = 0; m < 4; ++m) {
                const f32x4 cur = acc[ai][0][m][0]; f32x4 p1 = ror4(cur, 1), p2 = ror4(cur, 2);
                if (m > 0) { const f32x4 pv = acc[ai][0][m - 1][0]; const f32x4 q1 = ror4(pv, 1), q2 = ror4(pv, 2);
#pragma unroll
                    for (int e = 0; e < 4; ++e) { p1[e] = (fr == 0) ? q1[e] : p1[e]; p2[e] = (fr < 2) ? q2[e] : p2[e]; } }
                else { f32x4 h14 = (f32x4){0.f, 0.f, 0.f, 0.f}, h15 = h14;
                    if (!(wr == 0 && ai == 0)) { const int sai = (wr == 1) ? ai : 0, swr = (wr == 1) ? 0 : 1; const LAS float* hp = hl + ((((sai * 2 + swr) * 4 + wc) * 2 + 0) * 16 + fq * 4);
                        h14 = *(const LAS f32x4*)hp; h15 = *(const LAS f32x4*)(hp + 16); }
#pragma unroll
                    for (int e = 0; e < 4; ++e) { p1[e] = (fr == 0) ? h15[e] : p1[e]; p2[e] = (fr == 0) ? h14[e] : ((fr == 1) ? h15[e] : p2[e]); } }
                const f32x4 ya = acc[ai][1][m][0] * (w0 * p2 + w1 * p1 + w2 * cur);
                u32x2 w; w.x = cvt_pk_bf16(ya[0], ya[1]); w.y = cvt_pk_bf16(ya[2], ya[3]);
                const bool edge = (wr == 0 && ai == 0 && m == 0 && fr < 2 && !seq0);
                if (!edge) *(u32x2*)(mix + (size_t)(row0 + ai * 128 + m * 16) * 1024 + ch) = w;
            }
    }
};
struct EpiUpFused {
    bf16_t* act; const float* ssq; const float* cw; const float* cb; float* head; float* tail; LAS float* hl;
    __device__ __forceinline__ void operator()(f32x4 (&acc)[2][2][4][2], const Unit& u, int wr, int wc, int fr, int fq) const {
        fr = opq(fr); fq = opq(fq);
        const int row0 = u.pm * 256 + wr * 64 + fr, colg0 = u.pn * 128 + wc * 32 + 8 * fq;
        LAS float* rsL = hl + 2048; LAS float* cwL = hl + 2304;
        { const int t = (wc * 4 + fq) * 16 + fr;
          if (wr == 0) { const float* sp = ssq + ((size_t)u.pm * 256 + t) * 16; const f32x4 a = *(const f32x4*)sp, b = *(const f32x4*)(sp + 4), c = *(const f32x4*)(sp + 8), d = *(const f32x4*)(sp + 12);
              const f32x4 q = (a + b) + (c + d); rsL[t] = rsqrtf(((q[0] + q[1]) + (q[2] + q[3])) * (1.0f / 1024.0f) + EPS); }
          else { const int which = t >> 6, j = (t & 63) * 4, bj = j >> 7, c = j & 127; const float* src = (which < 3 ? cw + (size_t)which * NUP : cb) + bj * DFF + u.pn * 128 + c;
              *(LAS f32x4*)(cwL + which * 256 + j) = *(const f32x4*)src; } }
        if (fr >= 14) {
#pragma unroll
            for (int ai = 0; ai < 2; ++ai)
#pragma unroll
                for (int bj = 0; bj < 2; ++bj)
#pragma unroll
                    for (int n = 0; n < 2; ++n) *(LAS f32x4*)(hl + (((((ai * 2 + wr) * 4 + wc) * 2 + (fr - 14)) * 2 + bj) * 32 + 8 * fq + 4 * n)) = acc[ai][bj][3][n]; }
        asm volatile("s_waitcnt vmcnt(0) lgkmcnt(0)" ::: "memory"); __builtin_amdgcn_s_barrier(); asm volatile("" ::: "memory"); __builtin_amdgcn_s_barrier(); asm volatile("" ::: "memory");
        EPI_FOR_ROWS() { const float rs = rsL[ai * 128 + wr * 64 + m * 16 + fr];
#pragma unroll
            for (int bj = 0; bj < 2; ++bj) { acc[ai][bj][m][0] *= rs; acc[ai][bj][m][1] *= rs; } }
        if (wr == 1 && fr >= 14) {
#pragma unroll
            for (int bj = 0; bj < 2; ++bj)
#pragma unroll
                for (int n = 0; n < 2; ++n) *(f32x4*)(tail + ((size_t)u.pm * 2 + (fr - 14)) * NUP + bj * DFF + colg0 + 4 * n) = acc[1][bj][3][n]; }
        if (wr == 0 && fr < 2) {
#pragma unroll
            for (int bj = 0; bj < 2; ++bj)
#pragma unroll
                for (int n = 0; n < 2; ++n) *(f32x4*)(head + ((size_t)u.pm * 2 + fr) * NUP + bj * DFF + colg0 + 4 * n) = acc[0][bj][0][n]; }
        const bool seq0 = (u.pm & 15) == 0;
#pragma unroll
        for (int n = 0; n < 2; ++n) {
            const int lc = wc * 32 + 8 * fq + 4 * n + opq(0);
            const f32x4 wg0 = *(const LAS f32x4*)(cwL + lc), wg1 = *(const LAS f32x4*)(cwL + 256 + lc), wg2 = *(const LAS f32x4*)(cwL + 512 + lc), bg = *(const LAS f32x4*)(cwL + 768 + lc);
            const f32x4 wv0 = *(const LAS f32x4*)(cwL + 128 + lc), wv1 = *(const LAS f32x4*)(cwL + 384 + lc), wv2 = *(const LAS f32x4*)(cwL + 640 + lc), bv = *(const LAS f32x4*)(cwL + 896 + lc);
#pragma unroll
            for (int ai = 0; ai < 2; ++ai)
#pragma unroll
                for (int m = 0; m < 4; ++m) {
                    f32x4 gv[2];
#pragma unroll
                    for (int bj = 0; bj < 2; ++bj) {
                        const f32x4 cur = acc[ai][bj][m][n]; f32x4 p1 = ror4(cur, 1), p2 = ror4(cur, 2);
                        if (m > 0) { const f32x4 pv = acc[ai][bj][m - 1][n]; const f32x4 q1 = ror4(pv, 1), q2 = ror4(pv, 2);
#pragma unroll
                            for (int e = 0; e < 4; ++e) { p1[e] = (fr == 0) ? q1[e] : p1[e]; p2[e] = (fr < 2) ? q2[e] : p2[e]; } }
                        else { f32x4 h14 = (f32x4){0.f, 0.f, 0.f, 0.f}, h15 = h14;
                            if (!(wr == 0 && ai == 0)) { const int sai = (wr == 1) ? ai : 0, swr = (wr == 1) ? 0 : 1; const int ox = opq(0);
                                const LAS float* hp = hl + (((((sai * 2 + swr) * 4 + wc) * 2 + 0) * 2 + bj) * 32 + 8 * fq + 4 * n) + ox;
                                const float r14 = rsL[sai * 128 + swr * 64 + 62 + ox], r15 = rsL[sai * 128 + swr * 64 + 63 + ox];
                                h14 = *(const LAS f32x4*)hp * r14; h15 = *(const LAS f32x4*)(hp + 64) * r15; }
#pragma unroll
                            for (int e = 0; e < 4; ++e) { p1[e] = (fr == 0) ? h15[e] : p1[e]; p2[e] = (fr == 0) ? h14[e] : ((fr == 1) ? h15[e] : p2[e]); } }
                        const f32x4 w0 = bj ? wv0 : wg0, w1 = bj ? wv1 : wg1, w2 = bj ? wv2 : wg2, bb = bj ? bv : bg;
                        gv[bj] = bb + w0 * p2 + w1 * p1 + w2 * cur;
                    }
                    float o[4];
#pragma unroll
                    for (int e = 0; e < 4; ++e) o[e] = gv[0][e] * sigm(gv[0][e]) * gv[1][e];
                    u32x2 w; w.x = cvt_pk_bf16(o[0], o[1]); w.y = cvt_pk_bf16(o[2], o[3]);
                    const bool edge = (wr == 0 && ai == 0 && m == 0 && fr < 2 && !seq0);
                    if (!edge) *(u32x2*)(act + (size_t)(row0 + ai * 128 + m * 16) * DFF + colg0 + 4 * n) = w;
                    __builtin_amdgcn_sched_barrier(0);
                }
        }
    }
};
struct EpiS5a {
    static constexpr bool PF = false;
    float* sloc;
    __device__ __forceinline__ void operator()(const f32x4 (&acc)[2][2][4][2], const Unit& u, int wr, int wc, int fr, int fq) const {
        const int row0 = u.pm * 256 + wr * 64 + fr, col0 = wc * 32 + 8 * fq;
        EPI_FOR_ROWS() { float* rp = sloc + (size_t)(row0 + ai * 128 + m * 16) * 128 + col0; *(f32x4*)rp = acc[ai][0][m][0]; *(f32x4*)(rp + 4) = acc[ai][0][m][1]; }
    }
};
struct EpiPoolOut {
    static constexpr bool PF = false;
    bf16_t* mix;
    __device__ __forceinline__ void operator()(const f32x4 (&acc)[2][2][4][2], const Unit& u, int wr, int wc, int fr, int fq) const {
        EPI_ROWCOL();
        EPI_FOR_ROWS() {
#pragma unroll
            for (int bj = 0; bj < 2; ++bj) { const f32x4 v0 = acc[ai][bj][m][0], v1 = acc[ai][bj][m][1];
                u32x4 w; w.x = cvt_pk_bf16(v0[0], v0[1]); w.y = cvt_pk_bf16(v0[2], v0[3]); w.z = cvt_pk_bf16(v1[0], v1[1]); w.w = cvt_pk_bf16(v1[2], v1[3]);
                *(u32x4*)(mix + (size_t)(row0 + ai * 128 + m * 16) * 1024 + col0 + bj * 128) = w; } }
    }
};
struct EpiSguOut {
    static constexpr bool PF = false;
    const bf16_t* proj; const float* sb; bf16_t* mix;
    __device__ __forceinline__ void operator()(const f32x4 (&acc)[2][2][4][2], const Unit& u, int wr, int wc, int fr, int fq) const {
        EPI_ROWCOL();
        EPI_FOR_ROWS() { const int r = row0 + ai * 128 + m * 16, h = r >> 7, t = r & 127; const float bb = sb[r];
#pragma unroll
            for (int bj = 0; bj < 2; ++bj) { const int c = col0 + bj * 128, chunk = c >> 7, d = c & 127; const size_t tok = (size_t)chunk * 128 + t;
                const u32x4 sw = *(const u32x4*)(proj + tok * 1536 + 512 + h * 128 + d); float su[8]; UNPACK8(sw, su); const f32x4 a0 = acc[ai][bj][m][0] + bb, a1 = acc[ai][bj][m][1] + bb;
                u32x4 w; w.x = cvt_pk_bf16(a0[0] * su[0], a0[1] * su[1]); w.y = cvt_pk_bf16(a0[2] * su[2], a0[3] * su[3]); w.z = cvt_pk_bf16(a1[0] * su[4], a1[1] * su[5]); w.w = cvt_pk_bf16(a1[2] * su[6], a1[3] * su[7]);
                *(u32x4*)(mix + tok * 1024 + 512 + h * 128 + d) = w; } }
    }
};
struct EpiS5c {
    const bf16_t* a2; const float* dsk; bf16_t* yg;
    __device__ __forceinline__ void operator()(const f32x4 (&acc)[2][2][4][2], const Unit& u, int wr, int wc, int fr, int fq) const {
        const int row0 = u.pm * 256 + wr * 64 + fr, col0 = wc * 32 + 8 * fq; const int g = u.pn;
        EPI_FOR_ROWS() {
            const int gr = row0 + ai * 128 + m * 16, chunk = gr & 2047;
#pragma unroll
            for (int bj = 0; bj < 2; ++bj) { const int col = col0 + bj * 128, t = col >> 4, h0 = col & 15;
                const u32x4 uw = *(const u32x4*)(a2 + (size_t)gr * 384 + col); float uu[8]; UNPACK8(uw, uu);
                const f32x4 d0 = *(const f32x4*)(dsk + g * 16 + h0), d1 = *(const f32x4*)(dsk + g * 16 + h0 + 4); float o[8];
#pragma unroll
                for (int e = 0; e < 4; ++e) { o[e] = gelu_t(acc[ai][bj][m][0][e] + d0[e] * uu[e]); o[4 + e] = gelu_t(acc[ai][bj][m][1][e] + d1[e] * uu[4 + e]); }
                u32x4 w; w.x = cvt_pk_bf16(o[0], o[1]); w.y = cvt_pk_bf16(o[2], o[3]); w.z = cvt_pk_bf16(o[4], o[5]); w.w = cvt_pk_bf16(o[6], o[7]);
                *(u32x4*)(yg + ((size_t)chunk * 16 + t) * 512 + g * 16 + h0) = w; }
        }
    }
};
struct EpiGlu {
    const bf16_t* yg; bf16_t* mix; const float* gb;
    __device__ __forceinline__ void operator()(const f32x4 (&acc)[2][2][4][2], const Unit& u, int wr, int wc, int fr, int fq) const {
        EPI_ROWCOL();
        EPI_FOR_ROWS() {
            const int row = row0 + ai * 128 + m * 16;
#pragma unroll
            for (int bj = 0; bj < 2; ++bj) { const int col = col0 + bj * 128;
                const f32x4 b0 = *(const f32x4*)(gb + col), b1 = *(const f32x4*)(gb + col + 4);
                const u32x4 yw = *(const u32x4*)(yg + (size_t)row * 512 + col); float y[8]; UNPACK8(yw, y);
                const f32x4 a0 = acc[ai][bj][m][0] + b0, a1 = acc[ai][bj][m][1] + b1; float o[8];
#pragma unroll
                for (int e = 0; e < 4; ++e) { o[e] = y[e] * sigm(a0[e]); o[4 + e] = y[4 + e] * sigm(a1[e]); }
                u32x4 w; w.x = cvt_pk_bf16(o[0], o[1]); w.y = cvt_pk_bf16(o[2], o[3]); w.z = cvt_pk_bf16(o[4], o[5]); w.w = cvt_pk_bf16(o[6], o[7]);
                *(u32x4*)(mix + (size_t)row * 1024 + 512 + col) = w; }
        }
    }
};
struct EpiResid {
    bf16_t* xb; float* ssq;
    __device__ __forceinline__ void operator()(const f32x4 (&acc)[2][2][4][2], const Unit& u, int wr, int wc, int fr, int fq) const {
        EPI_ROWCOL();
        EPI_FOR_ROWS() {
            const int row = row0 + ai * 128 + m * 16; float ss = 0.f;
#pragma unroll
            for (int bj = 0; bj < 2; ++bj) { const int col = col0 + bj * 128; const size_t off = (size_t)row * 1024 + col;
                const u32x4 xw = *(const u32x4*)(xb + off); float xo[8]; UNPACK8(xw, xo);
                const f32x4 x0 = (f32x4){xo[0], xo[1], xo[2], xo[3]} + acc[ai][bj][m][0], x1 = (f32x4){xo[4], xo[5], xo[6], xo[7]} + acc[ai][bj][m][1];
                ss += (x0[0] * x0[0] + x0[1] * x0[1]) + (x0[2] * x0[2] + x0[3] * x0[3]) + (x1[0] * x1[0] + x1[1] * x1[1]) + (x1[2] * x1[2] + x1[3] * x1[3]);
                u32x4 w; w.x = cvt_pk_bf16(x0[0], x0[1]); w.y = cvt_pk_bf16(x0[2], x0[3]); w.z = cvt_pk_bf16(x1[0], x1[1]); w.w = cvt_pk_bf16(x1[2], x1[3]);
                *(u32x4*)(xb + off) = w; }
            ss += __shfl_xor(ss, 16); ss += __shfl_xor(ss, 32);
            if (fq == 0) ssq[(size_t)row * 16 + u.pn * 4 + wc] = ss;
        }
    }
};

__device__ __forceinline__ void cvt_matrix(const float* W, int K, int N, bf16_t* Wt, const float* gk, int upperm, LAS float* tile, int bid, int G, int tid) {
    const int nst = N / 256, ntiles = (K / 64) * nst;
    for (int ti = bid; ti < ntiles; ti += G) {
        const int kt = ti / nst, ns = ti % nst;
        { const int r = tid >> 3, cb = (tid & 7) * 8; const float s = gk ? gk[kt * 64 + r] : 1.0f;
#pragma unroll
          for (int q = 0; q < 4; ++q) { const int c = cb + 64 * q; const float* src = W + (size_t)(kt * 64 + r) * N + ns * 256 + c;
              const f32x4 v0 = *(const f32x4*)src, v1 = *(const f32x4*)(src + 4);
              LAS float* d = tile + r * 257 + c; d[0] = v0[0] * s; d[1] = v0[1] * s; d[2] = v0[2] * s; d[3] = v0[3] * s; d[4] = v1[0] * s; d[5] = v1[1] * s; d[6] = v1[2] * s; d[7] = v1[3] * s; } }
        __syncthreads();
        { const int n = tid >> 1, ks = (tid & 1) * 32; int nd = ns * 256 + n;
          if (upperm == 1) { nd = (nd < DFF) ? ((nd >> 7) * 256 + (nd & 127)) : (((nd - DFF) >> 7) * 256 + 128 + ((nd - DFF) & 127)); }
          if (upperm == 3) { const int ar = nd >> 9, ch = nd & 511, c64 = ch & 63, slot = (ar == 0) ? 0 : (ar == 2) ? 1 : (ar == 1) ? 2 : 3;
              nd = (ch >> 6) * 256 + 128 * (slot >> 1) + 32 * (c64 >> 4) + 8 * ((c64 >> 2) & 3) + 4 * (slot & 1) + (c64 & 3); }
          if (upperm == 2) { nd = (nd < 512) ? ((nd >> 7) * 256 + (nd & 127)) : (nd < 1024) ? (nd + 512) : (nd < 1536) ? (((nd - 1024) >> 7) * 256 + 128 + ((nd - 1024) & 127)) : nd; }
#pragma unroll
          for (int q = 0; q < 4; ++q) { const LAS float* sp = tile + (ks + 8 * q) * 257 + n;
              u32x4 w; w.x = cvt_pk_bf16(sp[0], sp[257]); w.y = cvt_pk_bf16(sp[514], sp[771]); w.z = cvt_pk_bf16(sp[1028], sp[1285]); w.w = cvt_pk_bf16(sp[1542], sp[1799]);
              *(u32x4*)(Wt + (size_t)nd * K + kt * 64 + ks + 8 * q) = w; } }
        __syncthreads();
    }
}
__device__ __forceinline__ void s5_setup(PCP p, int j, int g, int part, LAS float* lds, int tid) {
    LAS float* PW = lds;
    LAS float* BB = lds + 2176;
    LAS float* CC = BB + 2048;
    LAS float* KT = CC + 2048;
    const int jg = j * 32 + g;
    const double st = exp((double)p->in[4][jg]);
    for (int e = tid; e < 64 * 17; e += 512) { const int pp = e / 17, k = e % 17; const double are = p->in[5][jg * 64 + pp], aim = p->in[6][jg * 64 + pp];
        const double mag = exp(are * st * k), ang = aim * st * k; PW[e * 2] = (float)(mag * cos(ang)); PW[e * 2 + 1] = (float)(mag * sin(ang)); }
    for (int e = tid; e < 64 * 16; e += 512) { const int pp = e >> 4, h = e & 15; const double are = p->in[5][jg * 64 + pp], aim = p->in[6][jg * 64 + pp];
        const double mag = exp(are * st), ang = aim * st; const double nr = mag * cos(ang) - 1.0, ni = mag * sin(ang); const double den = are * are + aim * aim;
        const double qr = (nr * are + ni * aim) / den, qi = (ni * are - nr * aim) / den;
        const double br = p->in[7][((size_t)jg * 64 + pp) * 16 + h], bi = p->in[8][((size_t)jg * 64 + pp) * 16 + h];
        BB[e * 2] = (float)(qr * br - qi * bi); BB[e * 2 + 1] = (float)(qr * bi + qi * br); }
    for (int e = tid; e < 1024; e += 512) { CC[e * 2] = p->in[9][(size_t)jg * 1024 + e]; CC[e * 2 + 1] = p->in[10][(size_t)jg * 1024 + e]; }
    if (tid < 64 && part == 0) { const double are = p->in[5][jg * 64 + tid], aim = p->in[6][jg * 64 + tid]; float* lq = (float*)(p->ws + WS_LQ) + (size_t)j * 8192;
        { const double mag = exp(are * st * 16.0), ang = aim * st * 16.0; lq[(g * 64 + tid) * 2] = (float)(mag * cos(ang)); lq[(g * 64 + tid) * 2 + 1] = (float)(mag * sin(ang)); }
        { const double mag = exp(are * st * 512.0), ang = aim * st * 512.0; lq[4096 + (g * 64 + tid) * 2] = (float)(mag * cos(ang)); lq[4096 + (g * 64 + tid) * 2 + 1] = (float)(mag * sin(ang)); } }
    __syncthreads();
    for (int e = tid; e < 4096; e += 512) { const int tau = e >> 8, hp = (e >> 4) & 15, h = e & 15; float s = 0.f;
        for (int pp = 0; pp < 64; ++pp) { const float cr = CC[(hp * 64 + pp) * 2], ci = CC[(hp * 64 + pp) * 2 + 1], pr = PW[(pp * 17 + tau) * 2], pi = PW[(pp * 17 + tau) * 2 + 1];
            const float xr = cr * pr - ci * pi, xi = cr * pi + ci * pr; s += xr * BB[(pp * 16 + h) * 2] - xi * BB[(pp * 16 + h) * 2 + 1]; }
        KT[e] = s; }
    __syncthreads();
    bf16_t* mct = (bf16_t*)(p->ws + WS_MCT + (size_t)j * 6 * MiB) + (size_t)g * 256 * 384;
    for (int e = tid + part * 512; e < 256 * 384; e += 2048) { const int n = e / 384, k = e % 384, t = n >> 4, hp = n & 15; float v;
        if (k < 256) { const int s = k >> 4, h = k & 15; v = (s <= t) ? KT[((t - s) * 16 + hp) * 16 + h] : 0.f; }
        else { const int jj = k - 256, pp = jj & 63; const float cr = CC[(hp * 64 + pp) * 2], ci = CC[(hp * 64 + pp) * 2 + 1], pr = PW[(pp * 17 + t + 1) * 2], pi = PW[(pp * 17 + t + 1) * 2 + 1];
            v = (jj < 64) ? (cr * pr - ci * pi) : -(cr * pi + ci * pr); }
        mct[e] = f2bf(v); }
    bf16_t* bct = (bf16_t*)(p->ws + WS_BCT2 + (size_t)j * 4 * MiB) + (size_t)g * 256 * 256;
    for (int e = tid + part * 512; e < 128 * 256; e += 2048) bct[128 * 256 + e] = 0;
    for (int e = tid + part * 512; e < 128 * 256; e += 2048) { const int jj = e >> 8, k = e & 255, s = k >> 4, h = k & 15, pp = jj & 63;
        const float pr = PW[(pp * 17 + 15 - s) * 2], pi = PW[(pp * 17 + 15 - s) * 2 + 1], br = BB[(pp * 16 + h) * 2], bi = BB[(pp * 16 + h) * 2 + 1];
        bct[e] = f2bf((jj < 64) ? (pr * br - pi * bi) : (pr * bi + pi * br)); }
    __syncthreads();
}

__device__ __forceinline__ bf16_t* wl(PCP p, int i, size_t off) { return (bf16_t*)(p->ws + WS_W + (size_t)i * WL_STRIDE + off); }

__device__ __forceinline__ void phase0(PCP p, LAS unsigned char* lds, int bid, int G, int tid) {
    tid = opq(tid); p = opqp(p);
    LAS float* tile = (LAS float*)lds;
    const int wid = tid >> 6, lane = tid & 63;
    for (int i = 0; i < 4; ++i) {
        const int j = i >> 1;
        if ((i & 1) == 0) cvt_matrix(p->in[2] + (size_t)j * 1024 * 2048, 1024, 2048, wl(p, i, 0), p->in[1] + i * 1024, 3, tile, bid, G, tid);
        else              cvt_matrix(p->in[15] + (size_t)j * 1024 * 1536, 1024, 1536, wl(p, i, 0), p->in[1] + i * 1024, 0, tile, bid, G, tid);
        cvt_matrix(((i & 1) == 0 ? p->in[14] : p->in[21]) + (size_t)j * 1024 * 1024, 1024, 1024, wl(p, i, 4 * MiB), nullptr, 0, tile, bid, G, tid);
        cvt_matrix(p->in[23] + (size_t)i * 1024 * NUP, 1024, NUP, wl(p, i, 6 * MiB), p->in[22] + i * 1024, 1, tile, bid, G, tid);
        cvt_matrix(p->in[26] + (size_t)i * DFF * 1024, DFF, 1024, wl(p, i, 17 * MiB), nullptr, 0, tile, bid, G, tid);
    }
    for (int j = 0; j < 2; ++j) {
        cvt_matrix(p->in[12] + (size_t)j * 512 * 512, 512, 512, (bf16_t*)(p->ws + WS_GLU + (size_t)j * 512 * 1024), nullptr, 0, tile, bid, G, tid);
        { bf16_t* pwbd = (bf16_t*)(p->ws + WS_PWBD + (size_t)j * 512 * 1024); bf16_t* wsbd = (bf16_t*)(p->ws + WS_WSBD + (size_t)j * 512 * 1024);
          for (int e = bid * 512 + tid; e < 512 * 512; e += G * 512) { const int n = e >> 9, k = e & 511, gn = n >> 7, gk2 = k >> 7;
              pwbd[e] = f2bf(gn == gk2 ? p->in[16][(((size_t)j * 4 + gn) * 128 + (k & 127)) * 128 + (n & 127)] * p->in[17][j * 512 + n] : 0.f);
              wsbd[e] = f2bf((gn == gk2 && (k & 127) <= (n & 127)) ? p->in[19][(((size_t)j * 4 + gn) * 128 + (n & 127)) * 128 + (k & 127)] : 0.f); } }
    }
    for (int it = bid; it < 256; it += G) s5_setup(p, it >> 7, (it >> 2) & 31, it & 3, (LAS float*)lds, tid);
    { const float* x = p->in[0]; bf16_t* xb = (bf16_t*)(p->ws + WS_XB); float* ssq = (float*)(p->ws + WS_SSQ) + (size_t)16 * T;
      for (int row0 = (bid * 8 + wid) * 4; row0 < T; row0 += G * 8 * 4) { float ss[4]; f32x4 va[4][2], vb[4][2];
#pragma unroll
          for (int r = 0; r < 4; ++r)
#pragma unroll
              for (int h = 0; h < 2; ++h) { const float* xp = x + (size_t)(row0 + r) * 1024 + h * 512 + lane * 8; va[r][h] = *(const f32x4*)xp; vb[r][h] = *(const f32x4*)(xp + 4); }
#pragma unroll
          for (int r = 0; r < 4; ++r) { ss[r] = 0.f;
#pragma unroll
              for (int h = 0; h < 2; ++h) { const f32x4 a = va[r][h], b = vb[r][h];
                  ss[r] += (a[0] * a[0] + a[1] * a[1]) + (a[2] * a[2] + a[3] * a[3]) + (b[0] * b[0] + b[1] * b[1]) + (b[2] * b[2] + b[3] * b[3]);
                  u32x4 w; w.x = cvt_pk_bf16(a[0], a[1]); w.y = cvt_pk_bf16(a[2], a[3]); w.z = cvt_pk_bf16(b[0], b[1]); w.w = cvt_pk_bf16(b[2], b[3]);
                  *(u32x4*)(xb + (size_t)(row0 + r) * 1024 + h * 512 + lane * 8) = w; }
              ss[r] = wave_sum(ss[r]); if (lane < 16) ssq[(size_t)(row0 + r) * 16 + lane] = (lane == 0) ? ss[r] : 0.f; } } }
}

__device__ __forceinline__ void phase_evenfix(PCP p, int j, int bid, int G, int tid) {
    tid = opq(tid); p = opqp(p);
    const float* head = (const float*)(p->ws + WS_HEAD); const float* tail = (const float*)(p->ws + WS_TAIL); bf16_t* mix = (bf16_t*)(p->ws + WS_MIX); const float* cw = p->in[3] + (size_t)j * 3 * 512;
    for (int idx = bid * 512 + tid; idx < 128 * 2 * 128; idx += G * 512) {
        const int pm = idx >> 8, r = (idx >> 7) & 1, c = (idx & 127) * 4;
        if ((pm & 15) == 0) continue;
        const f32x4 q0 = *(const f32x4*)(head + (((size_t)pm * 2 + r) * 2 + 0) * 512 + c), ba = *(const f32x4*)(head + (((size_t)pm * 2 + r) * 2 + 1) * 512 + c);
        const f32x4 q1 = (r == 1) ? *(const f32x4*)(head + (((size_t)pm * 2 + 0) * 2 + 0) * 512 + c) : *(const f32x4*)(tail + ((size_t)(pm - 1) * 2 + 1) * 512 + c);
        const f32x4 q2 = (r == 1) ? *(const f32x4*)(tail + ((size_t)(pm - 1) * 2 + 1) * 512 + c) : *(const f32x4*)(tail + ((size_t)(pm - 1) * 2 + 0) * 512 + c);
        const f32x4 ya = ba * (*(const f32x4*)(cw + c) * q2 + *(const f32x4*)(cw + 512 + c) * q1 + *(const f32x4*)(cw + 1024 + c) * q0);
        u32x2 w; w.x = cvt_pk_bf16(ya[0], ya[1]); w.y = cvt_pk_bf16(ya[2], ya[3]);
        *(u32x2*)(mix + ((size_t)pm * 256 + r) * 1024 + c) = w;
    }
}
__device__ __forceinline__ void phase_s5(PCP p, int j, LAS float* lds, int bid, int G, int tid) {
    tid = opq(tid); p = opqp(p);
    const int wid = tid >> 6, lane = tid & 63;
    bf16_t* a2 = (bf16_t*)(p->ws + WS_A2); float* sloc = (float*)(p->ws + WS_SLOC); const float* lq = (const float*)(p->ws + WS_LQ) + (size_t)j * 8192;
    const bf16_t* bct = (const bf16_t*)(p->ws + WS_BCT + (size_t)j * 2 * MiB); const bf16_t* mct = (const bf16_t*)(p->ws + WS_MCT + (size_t)j * 6 * MiB); bf16_t* yg = (bf16_t*)(p->ws + WS_YG);
    for (int it = bid; it < 256; it += G) { const int b = it >> 5, g = it & 31;
        const size_t rowb = (size_t)g * 2048 + b * 256;
        { const float ar = lq[(g * 64 + lane) * 2], ai = lq[(g * 64 + lane) * 2 + 1], br = lq[4096 + (g * 64 + lane) * 2], bi = lq[4096 + (g * 64 + lane) * 2 + 1];
          const size_t row0 = rowb + wid * 32;
          float xr[32], xi[32];
#pragma unroll
          for (int c = 0; c < 32; ++c) { xr[c] = sloc[(row0 + c) * 128 + lane]; xi[c] = sloc[(row0 + c) * 128 + 64 + lane]; }
          float sr = 0.f, si = 0.f;
#pragma unroll
          for (int c = 0; c < 32; ++c) { const float nr = ar * sr - ai * si + xr[c], ni = ar * si + ai * sr + xi[c]; sr = nr; si = ni; }
          lds[(wid * 64 + lane) * 2] = sr; lds[(wid * 64 + lane) * 2 + 1] = si;
          __syncthreads();
          sr = 0.f; si = 0.f;
          for (int v = 0; v < wid; ++v) { const float er = lds[(v * 64 + lane) * 2], ei = lds[(v * 64 + lane) * 2 + 1]; const float nr = br * sr - bi * si + er, ni = br * si + bi * sr + ei; sr = nr; si = ni; }
#pragma unroll
          for (int c = 0; c < 32; ++c) { a2[(row0 + c) * 384 + 256 + lane] = f2bf(sr); a2[(row0 + c) * 384 + 320 + lane] = f2bf(si);
              const float nr = ar * sr - ai * si + xr[c], ni = ar * si + ai * sr + xi[c]; sr = nr; si = ni; } }
        __syncthreads();
    }
}
__device__ __forceinline__ void pool_chunk(PCP p, int chunk, int tid) {
    const bf16_t* proj = (const bf16_t*)(p->ws + WS_PROJ); bf16_t* pooled = (bf16_t*)(p->ws + WS_A2);
    { const int idx = chunk * 512 + tid;
        const int t0 = (idx >> 6) * 16, c = (idx & 63) * 8, pos0 = t0 & (SEQ - 1), w = 2 << (c >> 7);
        float s[8];
#pragma unroll
        for (int e = 0; e < 8; ++e) s[e] = 0.f;
#pragma unroll
        for (int k = 1; k < 16; ++k) { if (k < w && k <= pos0) { const u32x4 zw = *(const u32x4*)(proj + (size_t)(t0 - k) * 1536 + c); float q[8]; UNPACK8(zw, q);
#pragma unroll
            for (int e = 0; e < 8; ++e) s[e] += q[e]; } }
#pragma unroll
        for (int i = 0; i < 16; ++i) { const int t = t0 + i, pos = pos0 + i;
            const u32x4 zw = *(const u32x4*)(proj + (size_t)t * 1536 + c); float z[8]; UNPACK8(zw, z);
#pragma unroll
            for (int e = 0; e < 8; ++e) s[e] += z[e];
            const int cnt = (pos + 1 < w) ? pos + 1 : w; const float inv = 1.0f / (float)cnt;
            u32x4 o; o.x = cvt_pk_bf16(s[0] * inv - z[0], s[1] * inv - z[1]); o.y = cvt_pk_bf16(s[2] * inv - z[2], s[3] * inv - z[3]); o.z = cvt_pk_bf16(s[4] * inv - z[4], s[5] * inv - z[5]); o.w = cvt_pk_bf16(s[6] * inv - z[6], s[7] * inv - z[7]);
            *(u32x4*)(pooled + (size_t)t * 512 + c) = o;
            if (pos + 1 >= w) { const u32x4 ow = *(const u32x4*)(proj + (size_t)(t + 1 - w) * 1536 + c); float q[8]; UNPACK8(ow, q);
#pragma unroll
                for (int e = 0; e < 8; ++e) s[e] -= q[e]; } }
    }
}
__device__ __forceinline__ void sguprep_chunk(PCP p, int j, LAS unsigned char* lds, int it, int tid) {
    const int wid = tid >> 6, lane = tid & 63;
    const bf16_t* proj = (const bf16_t*)(p->ws + WS_PROJ); bf16_t* vt = (bf16_t*)(p->ws + WS_SLOC); const float* ng = p->in[18] + (size_t)j * 512;
    LAS float* rstd = (LAS float*)lds; LAS bf16_t* tl = (LAS bf16_t*)(lds + 1024);
    { const size_t T0 = (size_t)it * 128;
#pragma unroll
        for (int s0 = 0; s0 < 16; ++s0) { const int s = wid * 16 + s0; const u32x4 vw = *(const u32x4*)(proj + (T0 + s) * 1536 + 1024 + lane * 8); float v[8]; UNPACK8(vw, v); float ss = 0.f;
#pragma unroll
            for (int e = 0; e < 8; ++e) ss += v[e] * v[e];
            ss = wave_sum(ss); if (lane == 0) rstd[s] = rsqrtf(ss * (1.0f / 512.0f) + EPS); }
        __syncthreads();
        for (int h = 0; h < 4; ++h) {
            const int d0 = (tid & 15) * 8; const f32x4 g0 = *(const f32x4*)(ng + h * 128 + d0), g1 = *(const f32x4*)(ng + h * 128 + d0 + 4);
#pragma unroll
            for (int i = 0; i < 4; ++i) { const int s = (tid >> 4) + 32 * i; const u32x4 vw = *(const u32x4*)(proj + (T0 + s) * 1536 + 1024 + h * 128 + d0); float v[8]; UNPACK8(vw, v); const float rs = rstd[s];
#pragma unroll
                for (int e = 0; e < 4; ++e) { tl[(d0 + e) * 130 + s] = f2bf(v[e] * rs * g0[e]); tl[(d0 + 4 + e) * 130 + s] = f2bf(v[4 + e] * rs * g1[e]); } }
            __syncthreads();
#pragma unroll
            for (int i = 0; i < 4; ++i) { const int d = (tid >> 4) + 32 * i, s0 = (tid & 15) * 8; const LAS unsigned* src = (const LAS unsigned*)(tl + d * 130 + s0);
                u32x4 w; w.x = src[0]; w.y = src[1]; w.z = src[2]; w.w = src[3];
                *(u32x4*)(vt + ((size_t)it * 128 + d) * 512 + h * 128 + s0) = w; }
            __syncthreads();
        }
    }
}
__device__ __forceinline__ void phase_odd(PCP p, int j, LAS unsigned char* lds, int bid, int G, int tid) {
    tid = opq(tid); p = opqp(p);
    for (int it = bid; it < 256; it += G) {
        pool_chunk(p, it, tid);
        sguprep_chunk(p, j, lds, it, tid);
        __syncthreads();
    }
}
__device__ __forceinline__ void ffnfix_panel(PCP p, int i, int pm, int tid) {
    if ((pm & 15) == 0) return;
    const float* head = (const float*)(p->ws + WS_HEAD); const float* tail = (const float*)(p->ws + WS_TAIL); bf16_t* act = (bf16_t*)(p->ws + WS_ACT);
    const float* cw = p->in[24] + (size_t)i * 3 * NUP; const float* cb = p->in[25] + (size_t)i * NUP;
    for (int idx = tid; idx < 2 * 704; idx += 512) {
        const int r = idx / 704, c = (idx - r * 704) * 4;
        const float* h0 = head + ((size_t)pm * 2) * NUP; const float* t0 = tail + ((size_t)(pm - 1) * 2) * NUP;
        const float* r0 = (r == 1) ? h0 + NUP : h0;
        const float* r1 = (r == 1) ? h0 : t0 + NUP;
        const float* r2 = (r == 1) ? t0 + NUP : t0;
        const f32x4 g = *(const f32x4*)(cb + c) + *(const f32x4*)(cw + c) * *(const f32x4*)(r2 + c) + *(const f32x4*)(cw + NUP + c) * *(const f32x4*)(r1 + c) + *(const f32x4*)(cw + 2 * NUP + c) * *(const f32x4*)(r0 + c);
        const f32x4 v = *(const f32x4*)(cb + DFF + c) + *(const f32x4*)(cw + DFF + c) * *(const f32x4*)(r2 + DFF + c) + *(const f32x4*)(cw + NUP + DFF + c) * *(const f32x4*)(r1 + DFF + c) + *(const f32x4*)(cw + 2 * NUP + DFF + c) * *(const f32x4*)(r0 + DFF + c);
        u32x2 w; w.x = cvt_pk_bf16(g[0] * sigm(g[0]) * v[0], g[1] * sigm(g[1]) * v[1]); w.y = cvt_pk_bf16(g[2] * sigm(g[2]) * v[2], g[3] * sigm(g[3]) * v[3]);
        *(u32x2*)(act + ((size_t)pm * 256 + r) * DFF + c) = w;
    }
}
__device__ __forceinline__ void phase_final(PCP p, int bid, int G, int tid) {
    tid = opq(tid); p = opqp(p);
    const int wid = tid >> 6, lane = tid & 63; const float* ssq = (const float*)(p->ws + WS_SSQ) + (size_t)16 * T; const float* gf = p->in[27]; const bf16_t* xb = (const bf16_t*)(p->ws + WS_XB);
    for (int row = bid * 8 + wid; row < T; row += G * 8) { float sq = (lane < 16) ? ssq[(size_t)row * 16 + lane] : 0.f; sq = wave_sum(sq); const float rs = rsqrtf(sq * (1.0f / 1024.0f) + EPS);
#pragma unroll
        for (int q = 0; q < 2; ++q) { const int c = q * 512 + lane * 8; const u32x4 xw = *(const u32x4*)(xb + (size_t)row * 1024 + c); float x[8]; UNPACK8(xw, x);
            const f32x4 g0 = *(const f32x4*)(gf + c), g1 = *(const f32x4*)(gf + c + 4);
            *(f32x4*)(p->out + (size_t)row * 1024 + c) = (f32x4){x[0], x[1], x[2], x[3]} * rs * g0; *(f32x4*)(p->out + (size_t)row * 1024 + c + 4) = (f32x4){x[4], x[5], x[6], x[7]} * rs * g1; } }
}

#define GSYNC() xcd_barrier(xbar)
__global__ void __launch_bounds__(512, 2) mega(P parg) {
    extern __shared__ __attribute__((aligned(16))) unsigned char lds_raw[];
    LAS unsigned char* lds = (LAS unsigned char*)lds_raw;
    PCP p = (PCP)__builtin_amdgcn_kernarg_segment_ptr();
    if (parg.ws == nullptr) cg::this_grid().sync();
    const int tid = threadIdx.x, bid = blockIdx.x, G = gridDim.x;
    unsigned char* ws = p->ws;
    float* ssq0 = (float*)(ws + WS_SSQ); float* ssq1 = ssq0 + (size_t)16 * T;
    bf16_t* xb = (bf16_t*)(ws + WS_XB); bf16_t* proj = (bf16_t*)(ws + WS_PROJ); bf16_t* mix = (bf16_t*)(ws + WS_MIX); bf16_t* a2 = (bf16_t*)(ws + WS_A2); bf16_t* yg = (bf16_t*)(ws + WS_YG);
    bf16_t* act = (bf16_t*)(ws + WS_ACT);

    if (tid < 4) ((LAS unsigned*)(lds + LDS_BARW))[tid] = 0u;
    __syncthreads();
    XcdBarrier xbar = xcd_barrier_post((unsigned*)(ws + WS_BAR), (volatile LAS unsigned*)(lds + LDS_BARW));
    phase0(p, lds, bid, G, tid);
    GSYNC();
    for (int i = 0; i < 4; ++i) {
        const int j = i >> 1;
        if ((i & 1) == 0) {
            { pg8::Gemm g{xb, wl(p, i, 0), T, 2048, 1024, 1024, 1024}; pg8::StaticOrder S; S.init(T, 2048, G, bid); EpiProjEven4 E{mix, a2, ssq1, p->in[3] + (size_t)j * 3 * 512, (float*)(ws + WS_HEAD), (float*)(ws + WS_TAIL), (LAS float*)(lds + LDS_HALO)}; pg8::gemm_phase(lds, g, S, E);
            }
            GSYNC();
            { int k256 = 256; asm volatile("" : "+s"(k256));
              pg8::Gemm g{a2, (const bf16_t*)(ws + WS_BCT2 + (size_t)j * 4 * MiB), 65536, 8192, k256, 384, 256}; pg8::StaticOrder S; S.init_diag(256, G, bid); EpiS5a E{(float*)(ws + WS_SLOC)}; pg8::gemm_phase(lds, g, S, E); }
            GSYNC();
            phase_evenfix(p, j, bid, G, tid); phase_s5(p, j, (LAS float*)lds, bid, G, tid);
            GSYNC();
            { int k384 = 384; asm volatile("" : "+s"(k384));
              pg8::Gemm g{a2, (const bf16_t*)(ws + WS_MCT + (size_t)j * 6 * MiB), 65536, 8192, k384, 384, 384}; pg8::StaticOrder S; S.init_diag(256, G, bid); EpiS5c E{a2, p->in[11] + (size_t)j * 512, yg}; pg8::gemm_phase(lds, g, S, E); }
            GSYNC();
            { pg8::Gemm g{yg, (const bf16_t*)(ws + WS_GLU + (size_t)j * 512 * 1024), T, 512, 512, 512, 512}; pg8::StaticOrder S; S.init(T, 512, G, bid); EpiGlu E{yg, mix, p->in[13] + (size_t)j * 512}; pg8::gemm_phase(lds, g, S, E);
            }
            GSYNC();
        } else {
            { pg8::Gemm g{xb, wl(p, i, 0), T, 1536, 1024, 1024, 1024}; pg8::StaticOrder S; S.init(T, 1536, G, bid); EpiProjOdd E{proj, ssq1}; pg8::gemm_phase(lds, g, S, E);
            }
            GSYNC();
            phase_odd(p, j, lds, bid, G, tid);
            GSYNC();
            { int k512 = 512; asm volatile("" : "+s"(k512));
              { pg8::Gemm g{(const bf16_t*)(ws + WS_A2), (const bf16_t*)(ws + WS_PWBD + (size_t)j * 512 * 1024), T, 512, k512, 512, 512}; pg8::StaticOrder S; S.init(T, 512, G, bid); EpiPoolOut E{mix}; pg8::gemm_phase(lds, g, S, E); }
              { pg8::Gemm g{(const bf16_t*)(ws + WS_WSBD + (size_t)j * 512 * 1024), (const bf16_t*)(ws + WS_SLOC), 512, T, k512, 512, 512}; pg8::StaticOrder S; S.init(512, T, G, bid); EpiSguOut E{proj, p->in[20] + (size_t)j * 512, mix}; pg8::gemm_phase(lds, g, S, E); } }
            GSYNC();
        }
        { pg8::Gemm g{mix, wl(p, i, 4 * MiB), T, 1024, 1024, 1024, 1024}; pg8::StaticOrder S; S.init(T, 1024, G, bid);
          EpiResid E{xb, ssq0}; pg8::gemm_phase(lds, g, S, E);
        }
        GSYNC();
        { pg8::Gemm g{xb, wl(p, i, 6 * MiB), T, NUP, 1024, 1024, 1024}; pg8::StaticOrder S; S.init(T, NUP, G, bid);
          EpiUpFused E{act, ssq0, p->in[24] + (size_t)i * 3 * NUP, p->in[25] + (size_t)i * NUP, (float*)(ws + WS_HEAD), (float*)(ws + WS_TAIL), (LAS float*)(lds + LDS_HALO)}; pg8::gemm_phase(lds, g, S, E);
        }
        GSYNC();
        { pg8::Gemm g{act, wl(p, i, 17 * MiB), T, 1024, DFF, DFF, DFF}; pg8::StaticOrder S; S.init(T, 1024, G, bid); EpiResid E{xb, ssq1};
          { const int t2 = opq(tid); Unit fu; for (int ui = 0; S.next(ui, fu); ++ui) ffnfix_panel(p, i, fu.pm, t2); asm volatile("s_waitcnt vmcnt(0)" ::: "memory"); __syncthreads(); }
          pg8::gemm_phase(lds, g, S, E);
        }
        GSYNC();
    }
    phase_final(p, bid, G, tid);
}

extern "C" void kernel_launch(void* const* d_in, const int* in_sizes, int n_in, void* d_out, int out_size, void* d_ws, size_t ws_size, hipStream_t stream) {
    static int grid = 0;
    if (grid == 0) {
        if (n_in != 28 || out_size != T * D || ws_size < WS_END) { fprintf(stderr, "kernel_launch: unexpected shapes (n_in %d, out %d, ws %zu < %zu)\n", n_in, out_size, ws_size, (size_t)WS_END); }
        int dev = 0, cus = 0, per_cu = 0;
        hipGetDevice(&dev); hipDeviceGetAttribute(&cus, hipDeviceAttributeMultiprocessorCount, dev);
        hipFuncSetAttribute((const void*)mega, hipFuncAttributeMaxDynamicSharedMemorySize, LDS_BYTES);
        hipOccupancyMaxActiveBlocksPerMultiprocessor(&per_cu, (const void*)mega, 512, LDS_BYTES);
        (void)hipGetLastError();
        grid = cus > 0 ? cus : 256;
        if (per_cu < 1) fprintf(stderr, "kernel_launch: occupancy query reports %d blocks per CU\n", per_cu);
    }
    (void)hipMemsetAsync((char*)d_ws + WS_BAR, 0, 16384, stream);
    P p{};
    for (int i = 0; i < 28; ++i) p.in[i] = (const float*)d_in[i];
    p.out = (float*)d_out; p.ws = (unsigned char*)d_ws;
    void* args[] = {&p};
    hipError_t e = hipLaunchCooperativeKernel((const void*)mega, dim3(grid), dim3(512), args, LDS_BYTES, stream);
    if (e != hipSuccess) fprintf(stderr, "cooperative launch failed: %s (grid %d)\n", hipGetErrorString(e), grid);
}
```

```cpp
#include <hip/hip_runtime.h>
#include <hip/hip_cooperative_groups.h>
#include <cstdio>
namespace cg = cooperative_groups;

#define LAS __attribute__((address_space(3)))
typedef unsigned short bf16_t;
typedef short bf16x8 __attribute__((ext_vector_type(8)));
typedef float f32x4 __attribute__((ext_vector_type(4)));
typedef unsigned u32x4 __attribute__((ext_vector_type(4)));
typedef unsigned u32x2 __attribute__((ext_vector_type(2)));

constexpr int T = 32768, D = 1024, SEQ = 4096, DFF = 2816, NUP = 5632, TH = 16384;
constexpr float EPS = 1e-6f;
constexpr size_t MiB = 1ull << 20;
constexpr size_t WS_SSQ = 450 * MiB;
constexpr size_t WS_LQ = 2 * MiB;
constexpr size_t WS_W = 4 * MiB;
constexpr size_t WL_STRIDE = 23 * MiB;
constexpr size_t WS_GLU = 96 * MiB;
constexpr size_t WS_POOLW = 97 * MiB;
constexpr size_t WS_SGUW = 97 * MiB + 512 * 1024;
constexpr size_t WS_BCT = 98 * MiB;
constexpr size_t WS_MCT = 102 * MiB;
constexpr size_t WS_XB = 114 * MiB;
constexpr size_t WS_R = 178 * MiB;
constexpr size_t WS_PROJ = WS_R;
constexpr size_t WS_MIX = WS_R + 96 * MiB;
constexpr size_t WS_A2 = WS_R + 160 * MiB;
constexpr size_t WS_SLOC = WS_R + 208 * MiB;
constexpr size_t WS_YG = WS_R + 240 * MiB;
constexpr size_t WS_ACT = WS_R;
constexpr size_t WS_HEAD = 454 * MiB;
constexpr size_t WS_TAIL = 460 * MiB;
constexpr size_t WS_BAR = 3 * MiB;
constexpr size_t WS_BCT2 = 466 * MiB;
constexpr size_t WS_PWBD = 474 * MiB;
constexpr size_t WS_WSBD = 475 * MiB;
constexpr size_t WS_END = 476 * MiB;
constexpr int LDS_STAGE = 131072, LDS_BARW = LDS_STAGE, LDS_HALO = LDS_STAGE + 64, LDS_BYTES = LDS_STAGE + 64 + 8192 + 1024 + 4096;

struct P { const float* in[28]; float* out; unsigned char* ws; };
typedef const __attribute__((address_space(4))) P* PCP;

__device__ __forceinline__ unsigned cvt_pk_bf16(float lo, float hi) { unsigned r; asm volatile("v_cvt_pk_bf16_f32 %0, %1, %2" : "=v"(r) : "v"(lo), "v"(hi)); return r; }
__device__ __forceinline__ bf16_t f2bf(float f) { unsigned u = __float_as_uint(f); u += 0x7FFFu + ((u >> 16) & 1u); return (bf16_t)(u >> 16); }
__device__ __forceinline__ float bflo(unsigned w) { return __uint_as_float(w << 16); }
__device__ __forceinline__ float bfhi(unsigned w) { return __uint_as_float(w & 0xffff0000u); }
__device__ __forceinline__ float sigm(float x) { return __builtin_amdgcn_rcpf(1.0f + __expf(-x)); }
__device__ __forceinline__ float gelu_t(float x) { const float z = 1.5957691216f * (x + 0.044715f * x * x * x); return x * sigm(z); }
__device__ __forceinline__ PCP opqp(PCP q) { asm volatile("" : "+s"(q)); return q; }
__device__ __forceinline__ int opq(int v) { asm volatile("" : "+v"(v)); return v; }
__device__ __forceinline__ float wave_sum(float v) {
#pragma unroll
    for (int o = 32; o >= 1; o >>= 1) v += __shfl_xor(v, o);
    return v;
}
__device__ __forceinline__ void UNPACK8(const u32x4 q, float (&f)[8]) { f[0] = bflo(q.x); f[1] = bfhi(q.x); f[2] = bflo(q.y); f[3] = bfhi(q.y); f[4] = bflo(q.z); f[5] = bfhi(q.z); f[6] = bflo(q.w); f[7] = bfhi(q.w); }


#define XB_TMO      128
#define XB_XCNT(j)  (256  + 64 * (j))
#define XB_XSUB(j)  (1280 + 64 * (j))
#define XB_XGEN(j)  (2304 + 64 * (j))
#define XB_TOP      3328
#define XB_TOPGEN   3392
#define XCD_BAR_WORDS 3456
#define XB_SPIN_CAP (1u << 20)
__device__ __forceinline__ unsigned xb_ld(unsigned* p)              { return __hip_atomic_load(p, __ATOMIC_RELAXED, __HIP_MEMORY_SCOPE_AGENT); }
__device__ __forceinline__ unsigned xb_add(unsigned* p, unsigned v) { return __hip_atomic_fetch_add(p, v, __ATOMIC_RELAXED, __HIP_MEMORY_SCOPE_AGENT); }
__device__ __forceinline__ unsigned xb_xcc_id() { return (unsigned)__builtin_amdgcn_s_getreg((3 << 11) | 20) & 0xFu; }
#define XB_SPIN(cond, bar) do { unsigned _sp = 0; while (cond) { __builtin_amdgcn_s_sleep(1); \
    if ((++_sp & 255u) == 0u) { if (xb_ld(&(bar)[XB_TMO])) break; if (_sp > XB_SPIN_CAP) { atomicAdd(&(bar)[XB_TMO], 1u); break; } } } } while (0)
struct XcdBarrier { unsigned* bar; unsigned x; volatile LAS unsigned* st; };
__device__ __forceinline__ XcdBarrier xcd_barrier_post(unsigned* bar, volatile LAS unsigned* st) {
    XcdBarrier b; b.bar = bar; b.x = 0u; b.st = st;
    if (threadIdx.x == 0) { const unsigned x = xb_xcc_id(); st[2] = x; (void)xb_add(&bar[XB_XCNT(x)], 1u); }
    return b;
}
__device__ __forceinline__ void xcd_barrier_complete(unsigned* bar, unsigned x, unsigned& nloc, unsigned& nx) {
    const unsigned G = gridDim.x * gridDim.y * gridDim.z;
    unsigned sum, cnt, mine, sp = 0u;
    for (;;) {
        sum = 0u; cnt = 0u; mine = 0u;
#pragma unroll
        for (unsigned j = 0; j < 16; ++j) { const unsigned c = xb_ld(&bar[XB_XCNT(j)]); sum += c; cnt += (c > 0u) ? 1u : 0u; mine = (j == x) ? c : mine; }
        if (sum == G) break;
        __builtin_amdgcn_s_sleep(1);
        if ((++sp & 255u) == 0u) { if (xb_ld(&bar[XB_TMO])) break; if (sp > XB_SPIN_CAP) { atomicAdd(&bar[XB_TMO], 1u); break; } }
    }
    nloc = mine > 0u ? mine : 1u; nx = cnt > 0u ? cnt : 1u;
}
__device__ __forceinline__ void xcd_barrier(const XcdBarrier& b) {
    asm volatile("s_waitcnt vmcnt(0) lgkmcnt(0)" ::: "memory");
    __syncthreads();
    if (threadIdx.x == 0) {
        unsigned* bar = b.bar;
        __builtin_amdgcn_s_waitcnt(0);
        unsigned nloc = b.st[0], nx = b.st[1]; const unsigned bx = b.st[2];
        if (nloc == 0u) { xcd_barrier_complete(bar, bx, nloc, nx); b.st[0] = nloc; b.st[1] = nx; }
        const unsigned old = xb_add(&bar[XB_XSUB(bx)], 1u);
        const unsigned gen = old / nloc;
        if (old + 1u == (gen + 1u) * nloc) {
            __builtin_amdgcn_fence(__ATOMIC_RELEASE, "agent");
            asm volatile("s_waitcnt vmcnt(0)" ::: "memory");
            const unsigned og = xb_add(&bar[XB_TOP], 1u);
            const unsigned tg = og / nx;
            if (og + 1u == (tg + 1u) * nx) xb_add(&bar[XB_TOPGEN], 1u);
            else XB_SPIN(xb_ld(&bar[XB_TOPGEN]) == tg, bar);
            __builtin_amdgcn_fence(__ATOMIC_ACQUIRE, "agent");
            xb_add(&bar[XB_XGEN(bx)], 1u);
            asm volatile("s_waitcnt vmcnt(0)" ::: "memory");
        } else {
            XB_SPIN(xb_ld(&bar[XB_XGEN(bx)]) == gen, bar);
            __builtin_amdgcn_fence(__ATOMIC_ACQUIRE, "agent");
            asm volatile("s_waitcnt vmcnt(0)" ::: "memory");
        }
    }
    __syncthreads();
}

namespace pg8 {
constexpr int BM = 256, BK = 64, HALF = 128, HTB = HALF * BK * 2, STAGE_BYTES = 8 * HTB, NXCD = 8, WGM = 8;
__device__ __forceinline__ int lds_byte(int r, int c) { const int st = (r >> 4) * 2 + (c >> 5), rr = r & 15, cc = c & 31, ob = rr * 64 + cc * 2; return st * 1024 + (ob ^ (((ob >> 9) & 1) << 5)); }
__device__ __forceinline__ void stage_rc(int b, int& R, int& C) { const int st = b / 1024, sb = b % 1024, swz = sb ^ (((sb >> 9) & 1) << 5); R = (st >> 1) * 16 + swz / 64; C = (st & 1) * 32 + (swz % 64) / 2; }
__device__ __forceinline__ int perm32(int rho) { const int n = rho >> 4, i = rho & 15; return 8 * (i >> 2) + 4 * n + (i & 3); }

struct Unit { int pm, pn; };
struct Gemm { const bf16_t* A; const bf16_t* Bt; int M, N, K, lda, ldb; };

struct StaticOrder {
    int nM, nN, nwg, G, c, diag;
    __device__ void init(int M, int N, int G_, int c_) { nM = M / BM; nN = N / BM; nwg = nM * nN; G = G_; c = c_; diag = 0; }
    __device__ void init_diag(int nunits, int G_, int c_) { nM = nunits; nN = 1; nwg = nunits; G = G_; c = c_; diag = 1; }
    __device__ bool next(int i, Unit& u) const {
        const long L = (long)i * G + c; if (L >= nwg) return false;
        if (diag) { u.pm = (int)L; u.pn = (int)(L >> 3); return true; }
        int wgid = (int)L; { const int q = nwg / NXCD, r = nwg % NXCD, xcd = wgid % NXCD, off = wgid / NXCD; wgid = (xcd < r ? xcd * (q + 1) : r * (q + 1) + (xcd - r) * q) + off; }
        const int nig = WGM * nN, gid = wgid / nig, fm = gid * WGM, gsz = (nM - fm) < WGM ? (nM - fm) : WGM;
        u.pm = fm + ((wgid % nig) % gsz); u.pn = (wgid % nig) / gsz; return true;
    }
};

template <class Epi>
__device__ __forceinline__ void gemm_phase(LAS unsigned char* lds, const Gemm g, const StaticOrder& S, const Epi& E) {
    const int tid = opq(threadIdx.x), wid = __builtin_amdgcn_readfirstlane(tid >> 6), lane = tid & 63, wr = wid >> 2, wc = wid & 3, fr = lane & 15, fq = lane >> 4;
    const int K = g.K, nt = K / BK;
    unsigned voffA[2], voffB[2];
#pragma unroll
    for (int i = 0; i < 2; ++i) { int R, C; stage_rc(tid * 16 + i * 8192, R, C); const int Rb = (R & ~31) + perm32(R & 31);
        voffA[i] = (unsigned)(R * g.lda + C) * 2u; voffB[i] = (unsigned)(Rb * g.ldb + C) * 2u; }
    const size_t kstep = (size_t)(BK * 2);
    const size_t hstepA = (size_t)HALF * g.lda * 2, hstepB = (size_t)HALF * g.ldb * 2;
    const size_t tstepA = 2 * hstepA, tstepB = 2 * hstepB;
    const unsigned ldsw = (unsigned)wid * 1024u, ldsu = (unsigned)(unsigned long)lds;
    const int aoff = lds_byte(wr * 64 + fr, fq * 8), boff = lds_byte(wc * 32 + fr, fq * 8);
    int bbase[2][2];
#pragma unroll
    for (int b_ = 0; b_ < 2; ++b_)
#pragma unroll
        for (int h_ = 0; h_ < 2; ++h_) bbase[b_][h_] = opq(boff + (4 + b_ * 2 + h_) * HTB);
#define PG8_SA(b, h) (((b) * 2 + (h)) * HTB)
#define PG8_SB(b, h) ((4 + (b) * 2 + (h)) * HTB)
#define PG8_STAGE(bufoff, gbase, voff) do { _Pragma("unroll") for (int _i = 0; _i < 2; ++_i) { \
        const unsigned _m0 = ldsu + (unsigned)(bufoff) + ldsw + (unsigned)(_i * 8192); \
        asm volatile("s_mov_b32 m0, %2\n\ts_nop 0\n\tglobal_load_lds_dwordx4 %0, %1" :: "v"((voff)[_i]), "s"((const char*)(gbase)), "s"(_m0) : "memory"); } } while (0)
#define PG8_LDA(dst, b, h) do { _Pragma("unroll") for (int m = 0; m < 4; ++m) _Pragma("unroll") for (int k = 0; k < 2; ++k) dst[m][k] = *(const LAS bf16x8*)(lds + PG8_SA(b, h) + aoff + m * 2048 + k * 1024); } while (0)
#define PG8_LDB(dst, b, h) do { _Pragma("unroll") for (int n = 0; n < 2; ++n) _Pragma("unroll") for (int k = 0; k < 2; ++k) dst[n][k] = *(const LAS bf16x8*)(lds + bbase[b][h] + n * 2048 + k * 1024); } while (0)
#define PG8_MMA(ai, bj, At, Bt) do { __builtin_amdgcn_s_setprio(1); _Pragma("unroll") for (int m = 0; m < 4; ++m) _Pragma("unroll") for (int n = 0; n < 2; ++n) _Pragma("unroll") for (int k = 0; k < 2; ++k) \
        acc[ai][bj][m][n] = __builtin_amdgcn_mfma_f32_16x16x32_bf16(Bt[n][k], At[m][k], acc[ai][bj][m][n], 0, 0, 0); __builtin_amdgcn_s_setprio(0); } while (0)
#define PG8_MMA2(ai, At, Ba, Bb) do { __builtin_amdgcn_s_setprio(1); _Pragma("unroll") for (int m = 0; m < 4; ++m) _Pragma("unroll") for (int n = 0; n < 2; ++n) _Pragma("unroll") for (int k = 0; k < 2; ++k) \
        acc[ai][0][m][n] = __builtin_amdgcn_mfma_f32_16x16x32_bf16(Ba[n][k], At[m][k], acc[ai][0][m][n], 0, 0, 0); \
        _Pragma("unroll") for (int m = 0; m < 4; ++m) _Pragma("unroll") for (int n = 0; n < 2; ++n) _Pragma("unroll") for (int k = 0; k < 2; ++k) \
        acc[ai][1][m][n] = __builtin_amdgcn_mfma_f32_16x16x32_bf16(Bb[n][k], At[m][k], acc[ai][1][m][n], 0, 0, 0); __builtin_amdgcn_s_setprio(0); } while (0)
#define PG8_WAIT_V(n) asm volatile("s_waitcnt vmcnt(" #n ")" ::: "memory")
#define PG8_WAIT_L(n) asm volatile("s_waitcnt lgkmcnt(" #n ")" ::: "memory")
#define PG8_BAR __builtin_amdgcn_s_barrier()
#define PG8_SCHED __builtin_amdgcn_sched_barrier(0)
    Unit cur, nxt; int ui = 0;
    if (!S.next(0, cur)) return;
    f32x4 acc[2][2][4][2];
#pragma unroll
    for (int a = 0; a < 2; ++a)
#pragma unroll
        for (int b = 0; b < 2; ++b)
#pragma unroll
            for (int m = 0; m < 4; ++m)
#pragma unroll
                for (int n = 0; n < 2; ++n) acc[a][b][m][n] = (f32x4){0.f, 0.f, 0.f, 0.f};
    bf16x8 At[4][2], B0[2][2], B1[2][2];
    const char* cA = (const char*)g.A + (size_t)cur.pm * tstepA; const char* cB = (const char*)g.Bt + (size_t)cur.pn * tstepB;
    PG8_STAGE(PG8_SB(0, 0), cB, voffB); PG8_STAGE(PG8_SB(0, 1), cB + hstepB, voffB); PG8_STAGE(PG8_SA(0, 0), cA, voffA); PG8_STAGE(PG8_SA(0, 1), cA + hstepA, voffA);
    if (wr == 1) PG8_BAR;
    PG8_WAIT_V(2); PG8_BAR;
    PG8_STAGE(PG8_SB(1, 0), cB + kstep, voffB); PG8_STAGE(PG8_SA(1, 0), cA + kstep, voffA); PG8_STAGE(PG8_SB(1, 1), cB + hstepB + kstep, voffB);
    PG8_WAIT_V(6); PG8_BAR;
    for (;;) {
        const bool has_next = S.next(ui + 1, nxt);
        const char* nA = has_next ? (const char*)g.A + (size_t)nxt.pm * tstepA : cA; const char* nB = has_next ? (const char*)g.Bt + (size_t)nxt.pn * tstepB : cB;
        for (int t = 0; t < nt; t += 2) {
            const bool last = (t == nt - 2);
            const char* a1 = cA + (size_t)(t + 1) * kstep;
            const char* a2 = last ? nA : cA + (size_t)(t + 2) * kstep; const char* b2 = last ? nB : cB + (size_t)(t + 2) * kstep;
            const char* a3 = a2 + kstep; const char* b3 = b2 + kstep;
            PG8_LDB(B0, 0, 0); PG8_LDB(B1, 0, 1); PG8_SCHED; PG8_LDA(At, 0, 0); PG8_STAGE(PG8_SA(1, 1), a1 + hstepA, voffA);
            PG8_WAIT_V(8); PG8_WAIT_L(0); PG8_BAR; PG8_MMA2(0, At, B0, B1); PG8_BAR; PG8_SCHED;
            PG8_LDA(At, 0, 1); PG8_STAGE(PG8_SB(0, 0), b2, voffB); PG8_STAGE(PG8_SB(0, 1), b2 + hstepB, voffB); PG8_STAGE(PG8_SA(0, 0), a2, voffA);
            PG8_WAIT_V(8); PG8_WAIT_L(0); PG8_BAR; PG8_MMA2(1, At, B0, B1); PG8_BAR; PG8_SCHED;
            PG8_LDB(B0, 1, 0); PG8_LDB(B1, 1, 1); PG8_SCHED; PG8_LDA(At, 1, 0); PG8_STAGE(PG8_SA(0, 1), a2 + hstepA, voffA);
            PG8_WAIT_V(8); PG8_WAIT_L(0); PG8_BAR; PG8_MMA2(0, At, B0, B1); PG8_BAR; PG8_SCHED;
            PG8_LDA(At, 1, 1); PG8_STAGE(PG8_SB(1, 0), b3, voffB); PG8_STAGE(PG8_SB(1, 1), b3 + hstepB, voffB); PG8_STAGE(PG8_SA(1, 0), a3, voffA);
            PG8_WAIT_V(8); PG8_WAIT_L(0); PG8_BAR; PG8_MMA2(1, At, B0, B1); PG8_BAR; PG8_SCHED;
        }
        if (wr == 0) PG8_BAR;
        E(acc, cur, wr, wc, fr, fq);
        if (!has_next) break;
#pragma unroll
        for (int a = 0; a < 2; ++a)
#pragma unroll
            for (int b = 0; b < 2; ++b)
#pragma unroll
                for (int m = 0; m < 4; ++m)
#pragma unroll
                    for (int n = 0; n < 2; ++n) acc[a][b][m][n] = (f32x4){0.f, 0.f, 0.f, 0.f};
        cur = nxt; cA = nA; cB = nB; ++ui;
        if (wr == 1) PG8_BAR;
    }
    PG8_WAIT_V(0);
    PG8_BAR;
#undef PG8_SA
#undef PG8_SB
#undef PG8_STAGE
#undef PG8_LDA
#undef PG8_LDB
#undef PG8_MMA
#undef PG8_MMA2
#undef PG8_WAIT_V
#undef PG8_WAIT_L
#undef PG8_BAR
#undef PG8_SCHED
}
}
using pg8::Unit;

__device__ __forceinline__ float row_rstd(const float* ssq, int row, int fq) {
    const f32x4 q = *(const f32x4*)(ssq + (size_t)row * 16 + 4 * fq); float s = (q[0] + q[1]) + (q[2] + q[3]);
    s += __shfl_xor(s, 16); s += __shfl_xor(s, 32); return rsqrtf(s * (1.0f / 1024.0f) + EPS);
}
#define EPI_ROWCOL() const int row0 = u.pm * 256 + wr * 64 + fr, col0 = u.pn * 256 + wc * 32 + 8 * fq
#define EPI_FOR_ROWS() _Pragma("unroll") for (int ai = 0; ai < 2; ++ai) _Pragma("unroll") for (int m = 0; m < 4; ++m)

struct EpiProjOdd {
    bf16_t* proj; const float* ssq;
    __device__ __forceinline__ void operator()(const f32x4 (&acc)[2][2][4][2], const Unit& u, int wr, int wc, int fr, int fq) const {
        EPI_ROWCOL();
        EPI_FOR_ROWS() {
            const int row = row0 + ai * 128 + m * 16; const float rs = row_rstd(ssq, row, fq);
#pragma unroll
            for (int bj = 0; bj < 2; ++bj) { const int col = col0 + bj * 128; f32x4 v0 = acc[ai][bj][m][0] * rs, v1 = acc[ai][bj][m][1] * rs;
                if (u.pn >= 2) {
#pragma unroll
                    for (int e = 0; e < 4; ++e) { v0[e] = gelu_t(v0[e]); v1[e] = gelu_t(v1[e]); } }
                u32x4 w; w.x = cvt_pk_bf16(v0[0], v0[1]); w.y = cvt_pk_bf16(v0[2], v0[3]); w.z = cvt_pk_bf16(v1[0], v1[1]); w.w = cvt_pk_bf16(v1[2], v1[3]);
                *(u32x4*)(proj + (size_t)row * 1536 + col) = w; }
        }
    }
};
__device__ __forceinline__ f32x4 ror4(const f32x4 v, const int which) {
    f32x4 r;
#pragma unroll
    for (int e = 0; e < 4; ++e) { const int x = __float_as_int(v[e]); r[e] = __int_as_float(which == 1 ? __builtin_amdgcn_update_dpp(x, x, 0x121, 0xf, 0xf, false) : __builtin_amdgcn_update_dpp(x, x, 0x122, 0xf, 0xf, false)); }
    return r;
}
struct EpiProjEven4 {
    bf16_t* mix; bf16_t* a2; const float* ssq; const float* cw; float* head; float* tail; LAS float* hl;
    __device__ __forceinline__ void operator()(f32x4 (&acc)[2][2][4][2], const Unit& u, int wr, int wc, int fr, int fq) const {
        fr = opq(fr); fq = opq(fq);
        const int row0 = u.pm * 256 + wr * 64 + fr, ch = u.pn * 64 + wc * 16 + fq * 4;
        EPI_FOR_ROWS() { const int row = row0 + ai * 128 + m * 16; const float rs = row_rstd(ssq, row, fq);
            acc[ai][0][m][0] = (acc[ai][0][m][0] * rs) * (acc[ai][0][m][1] * rs); acc[ai][1][m][0] *= rs;
            const f32x4 uu = acc[ai][1][m][1] * rs; u32x2 w; w.x = cvt_pk_bf16(uu[0], uu[1]); w.y = cvt_pk_bf16(uu[2], uu[3]);
            *(u32x2*)(a2 + ((size_t)(ch >> 4) * 2048 + (row >> 4)) * 384 + (row & 15) * 16 + (ch & 15)) = w; }
        if (fr >= 14) {
#pragma unroll
            for (int ai = 0; ai < 2; ++ai) *(LAS f32x4*)(hl + ((((ai * 2 + wr) * 4 + wc) * 2 + (fr - 14)) * 16 + fq * 4)) = acc[ai][0][3][0];
            if (wr == 1) *(f32x4*)(tail + ((size_t)u.pm * 2 + (fr - 14)) * 512 + ch) = acc[1][0][3][0]; }
        if (wr == 0 && fr < 2) { *(f32x4*)(head + (((size_t)u.pm * 2 + fr) * 2 + 0) * 512 + ch) = acc[0][0][0][0]; *(f32x4*)(head + (((size_t)u.pm * 2 + fr) * 2 + 1) * 512 + ch) = acc[0][1][0][0]; }
        asm volatile("s_waitcnt lgkmcnt(0)" ::: "memory"); __builtin_amdgcn_s_barrier(); asm volatile("" ::: "memory");
        const f32x4 w0 = *(const f32x4*)(cw + ch), w1 = *(const f32x4*)(cw + 512 + ch), w2 = *(const f32x4*)(cw + 1024 + ch);
        const bool seq0 = (u.pm & 15) == 0;
#pragma unroll
        for (int ai = 0; ai < 2; ++ai)
#pragma unroll
            for (int m = 0; m < 4; ++m) {
                const f32x4 cur = acc[ai][0][m][0]; f32x4 p1 = ror4(cur, 1), p2 = ror4(cur, 2);
                if (m > 0) { const f32x4 pv = acc[ai][0][m - 1][0]; const f32x4 q1 = ror4(pv, 1), q2 = ror4(pv, 2);
#pragma unroll
                    for (int e = 0; e < 4; ++e) { p1[e] = (fr == 0) ? q1[e] : p1[e]; p2[e] = (fr < 2) ? q2[e] : p2[e]; } }
                else { f32x4 h14 = (f32x4){0.f, 0.f, 0.f, 0.f}, h15 = h14;
                    if (!(wr == 0 && ai == 0)) { const int sai = (wr == 1) ? ai : 0, swr = (wr == 1) ? 0 : 1; const LAS float* hp = hl + ((((sai * 2 + swr) * 4 + wc) * 2 + 0) * 16 + fq * 4);
                        h14 = *(const LAS f32x4*)hp; h15 = *(const LAS f32x4*)(hp + 16); }
#pragma unroll
                    for (int e = 0; e < 4; ++e) { p1[e] = (fr == 0) ? h15[e] : p1[e]; p2[e] = (fr == 0) ? h14[e] : ((fr == 1) ? h15[e] : p2[e]); } }
                const f32x4 ya = acc[ai][1][m][0] * (w0 * p2 + w1 * p1 + w2 * cur);
                u32x2 w; w.x = cvt_pk_bf16(ya[0], ya[1]); w.y = cvt_pk_bf16(ya[2], ya[3]);
                const bool edge = (wr == 0 && ai == 0 && m == 0 && fr < 2 && !seq0);
                if (!edge) *(u32x2*)(mix + (size_t)(row0 + ai * 128 + m * 16) * 1024 + ch) = w;
            }
    }
};
struct EpiUpFused {
    bf16_t* act; const float* ssq; const float* cw; const float* cb; float* head; float* tail; LAS float* hl;
    __device__ __forceinline__ void operator()(f32x4 (&acc)[2][2][4][2], const Unit& u, int wr, int wc, int fr, int fq) const {
        fr = opq(fr); fq = opq(fq);
        const int row0 = u.pm * 256 + wr * 64 + fr, colg0 = u.pn * 128 + wc * 32 + 8 * fq;
        LAS float* rsL = hl + 2048; LAS float* cwL = hl + 2304;
        { const int t = (wc * 4 + fq) * 16 + fr;
          if (wr == 0) { const float* sp = ssq + ((size_t)u.pm * 256 + t) * 16; const f32x4 a = *(const f32x4*)sp, b = *(const f32x4*)(sp + 4), c = *(const f32x4*)(sp + 8), d = *(const f32x4*)(sp + 12);
              const f32x4 q = (a + b) + (c + d); rsL[t] = rsqrtf(((q[0] + q[1]) + (q[2] + q[3])) * (1.0f / 1024.0f) + EPS); }
          else { const int which = t >> 6, j = (t & 63) * 4, bj = j >> 7, c = j & 127; const float* src = (which < 3 ? cw + (size_t)which * NUP : cb) + bj * DFF + u.pn * 128 + c;
              *(LAS f32x4*)(cwL + which * 256 + j) = *(const f32x4*)src; } }
        if (fr >= 14) {
#pragma unroll
            for (int ai = 0; ai < 2; ++ai)
#pragma unroll
                for (int bj = 0; bj < 2; ++bj)
#pragma unroll
                    for (int n = 0; n < 2; ++n) *(LAS f32x4*)(hl + (((((ai * 2 + wr) * 4 + wc) * 2 + (fr - 14)) * 2 + bj) * 32 + 8 * fq + 4 * n)) = acc[ai][bj][3][n]; }
        asm volatile("s_waitcnt vmcnt(0) lgkmcnt(0)" ::: "memory"); __builtin_amdgcn_s_barrier(); asm volatile("" ::: "memory"); __builtin_amdgcn_s_barrier(); asm volatile("" ::: "memory");
        EPI_FOR_ROWS() { const float rs = rsL[ai * 128 + wr * 64 + m * 16 + fr];
#pragma unroll
            for (int bj = 0; bj < 2; ++bj) { acc[ai][bj][m][0] *= rs; acc[ai][bj][m][1] *= rs; } }
        if (wr == 1 && fr >= 14) {
#pragma unroll
            for (int bj = 0; bj < 2; ++bj)
#pragma unroll
                for (int n = 0; n < 2; ++n) *(f32x4*)(tail + ((size_t)u.pm * 2 + (fr - 14)) * NUP + bj * DFF + colg0 + 4 * n) = acc[1][bj][3][n]; }
        if (wr == 0 && fr < 2) {
#pragma unroll
            for (int bj = 0; bj < 2; ++bj)
#pragma unroll
                for (int n = 0; n < 2; ++n) *(f32x4*)(head + ((size_t)u.pm * 2 + fr) * NUP + bj * DFF + colg0 + 4 * n) = acc[0][bj][0][n]; }
        const bool seq0 = (u.pm & 15) == 0;
#pragma unroll
        for (int n = 0; n < 2; ++n) {
            const int lc = wc * 32 + 8 * fq + 4 * n + opq(0);
            const f32x4 wg0 = *(const LAS f32x4*)(cwL + lc), wg1 = *(const LAS f32x4*)(cwL + 256 + lc), wg2 = *(const LAS f32x4*)(cwL + 512 + lc), bg = *(const LAS f32x4*)(cwL + 768 + lc);
            const f32x4 wv0 = *(const LAS f32x4*)(cwL + 128 + lc), wv1 = *(const LAS f32x4*)(cwL + 384 + lc), wv2 = *(const LAS f32x4*)(cwL + 640 + lc), bv = *(const LAS f32x4*)(cwL + 896 + lc);
#pragma unroll
            for (int ai = 0; ai < 2; ++ai)
#pragma unroll
                for (int m = 0; m < 4; ++m) {
                    f32x4 gv[2];
#pragma unroll
                    for (int bj = 0; bj < 2; ++bj) {
                        const f32x4 cur = acc[ai][bj][m][n]; f32x4 p1 = ror4(cur, 1), p2 = ror4(cur, 2);
                        if (m > 0) { const f32x4 pv = acc[ai][bj][m - 1][n]; const f32x4 q1 = ror4(pv, 1), q2 = ror4(pv, 2);
#pragma unroll
                            for (int e = 0; e < 4; ++e) { p1[e] = (fr == 0) ? q1[e] : p1[e]; p2[e] = (fr < 2) ? q2[e] : p2[e]; } }
                        else { f32x4 h14 = (f32x4){0.f, 0.f, 0.f, 0.f}, h15 = h14;
                            if (!(wr == 0 && ai == 0)) { const int sai = (wr == 1) ? ai : 0, swr = (wr == 1) ? 0 : 1; const int ox = opq(0);
                                const LAS float* hp = hl + (((((sai * 2 + swr) * 4 + wc) * 2 + 0) * 2 + bj) * 32 + 8 * fq + 4 * n) + ox;
                                const float r14 = rsL[sai * 128 + swr * 64 + 62 + ox], r15 = rsL[sai * 128 + swr * 64 + 63 + ox];
                                h14 = *(const LAS f32x4*)hp * r14; h15 = *(const LAS f32x4*)(hp + 64) * r15; }
#pragma unroll
                            for (int e = 0; e < 4; ++e) { p1[e] = (fr == 0) ? h15[e] : p1[e]; p2[e] = (fr == 0) ? h14[e] : ((fr == 1) ? h15[e] : p2[e]); } }
                        const f32x4 w0 = bj ? wv0 : wg0, w1 = bj ? wv1 : wg1, w2 = bj ? wv2 : wg2, bb = bj ? bv : bg;
                        gv[bj] = bb + w0 * p2 + w1 * p1 + w2 * cur;
                    }
                    float o[4];
#pragma unroll
                    for (int e = 0; e < 4; ++e) o[e] = gv[0][e] * sigm(gv[0][e]) * gv[1][e];
                    u32x2 w; w.x = cvt_pk_bf16(o[0], o[1]); w.y = cvt_pk_bf16(o[2], o[3]);
                    const bool edge = (wr == 0 && ai == 0 && m == 0 && fr < 2 && !seq0);
                    if (!edge) *(u32x2*)(act + (size_t)(row0 + ai * 128 + m * 16) * DFF + colg0 + 4 * n) = w;
                    __builtin_amdgcn_sched_barrier(0);
                }
        }
    }
};
struct EpiS5a {
    static constexpr bool PF = false;
    float* sloc;
    __device__ __forceinline__ void operator()(const f32x4 (&acc)[2][2][4][2], const Unit& u, int wr, int wc, int fr, int fq) const {
        const int row0 = u.pm * 256 + wr * 64 + fr, col0 = wc * 32 + 8 * fq;
        EPI_FOR_ROWS() { float* rp = sloc + (size_t)(row0 + ai * 128 + m * 16) * 128 + col0; *(f32x4*)rp = acc[ai][0][m][0]; *(f32x4*)(rp + 4) = acc[ai][0][m][1]; }
    }
};
struct EpiPoolOut {
    static constexpr bool PF = false;
    bf16_t* mix;
    __device__ __forceinline__ void operator()(const f32x4 (&acc)[2][2][4][2], const Unit& u, int wr, int wc, int fr, int fq) const {
        EPI_ROWCOL();
        EPI_FOR_ROWS() {
#pragma unroll
            for (int bj = 0; bj < 2; ++bj) { const f32x4 v0 = acc[ai][bj][m][0], v1 = acc[ai][bj][m][1];
                u32x4 w; w.x = cvt_pk_bf16(v0[0], v0[1]); w.y = cvt_pk_bf16(v0[2], v0[3]); w.z = cvt_pk_bf16(v1[0], v1[1]); w.w = cvt_pk_bf16(v1[2], v1[3]);
                *(u32x4*)(mix + (size_t)(row0 + ai * 128 + m * 16) * 1024 + col0 + bj * 128) = w; } }
    }
};
struct EpiSguOut {
    static constexpr bool PF = false;
    const bf16_t* proj; const float* sb; bf16_t* mix;
    __device__ __forceinline__ void operator()(const f32x4 (&acc)[2][2][4][2], const Unit& u, int wr, int wc, int fr, int fq) const {
        EPI_ROWCOL();
        EPI_FOR_ROWS() { const int r = row0 + ai * 128 + m * 16, h = r >> 7, t = r & 127; const float bb = sb[r];
#pragma unroll
            for (int bj = 0; bj < 2; ++bj) { const int c = col0 + bj * 128, chunk = c >> 7, d = c & 127; const size_t tok = (size_t)chunk * 128 + t;
                const u32x4 sw = *(const u32x4*)(proj + tok * 1536 + 512 + h * 128 + d); float su[8]; UNPACK8(sw, su); const f32x4 a0 = acc[ai][bj][m][0] + bb, a1 = acc[ai][bj][m][1] + bb;
                u32x4 w; w.x = cvt_pk_bf16(a0[0] * su[0], a0[1] * su[1]); w.y = cvt_pk_bf16(a0[2] * su[2], a0[3] * su[3]); w.z = cvt_pk_bf16(a1[0] * su[4], a1[1] * su[5]); w.w = cvt_pk_bf16(a1[2] * su[6], a1[3] * su[7]);
                *(u32x4*)(mix + tok * 1024 + 512 + h * 128 + d) = w; } }
    }
};
struct EpiS5c {
    const bf16_t* a2; const float* dsk; bf16_t* yg;
    __device__ __forceinline__ void operator()(const f32x4 (&acc)[2][2][4][2], const Unit& u, int wr, int wc, int fr, int fq) const {
        const int row0 = u.pm * 256 + wr * 64 + fr, col0 = wc * 32 + 8 * fq; const int g = u.pn;
        EPI_FOR_ROWS() {
            const int gr = row0 + ai * 128 + m * 16, chunk = gr & 2047;
#pragma unroll
            for (int bj = 0; bj < 2; ++bj) { const int col = col0 + bj * 128, t = col >> 4, h0 = col & 15;
                const u32x4 uw = *(const u32x4*)(a2 + (size_t)gr * 384 + col); float uu[8]; UNPACK8(uw, uu);
                const f32x4 d0 = *(const f32x4*)(dsk + g * 16 + h0), d1 = *(const f32x4*)(dsk + g * 16 + h0 + 4); float o[8];
#pragma unroll
                for (int e = 0; e < 4; ++e) { o[e] = gelu_t(acc[ai][bj][m][0][e] + d0[e] * uu[e]); o[4 + e] = gelu_t(acc[ai][bj][m][1][e] + d1[e] * uu[4 + e]); }
                u32x4 w; w.x = cvt_pk_bf16(o[0], o[1]); w.y = cvt_pk_bf16(o[2], o[3]); w.z = cvt_pk_bf16(o[4], o[5]); w.w = cvt_pk_bf16(o[6], o[7]);
                *(u32x4*)(yg + ((size_t)chunk * 16 + t) * 512 + g * 16 + h0) = w; }
        }
    }
};
struct EpiGlu {
    const bf16_t* yg; bf16_t* mix; const float* gb;
    __device__ __forceinline__ void operator()(const f32x4 (&acc)[2][2][4][2], const Unit& u, int wr, int wc, int fr, int fq) const {
        EPI_ROWCOL();
        EPI_FOR_ROWS() {
            const int row = row0 + ai * 128 + m * 16;
#pragma unroll
            for (int bj = 0; bj < 2; ++bj) { const int col = col0 + bj * 128;
                const f32x4 b0 = *(const f32x4*)(gb + col), b1 = *(const f32x4*)(gb + col + 4);
                const u32x4 yw = *(const u32x4*)(yg + (size_t)row * 512 + col); float y[8]; UNPACK8(yw, y);
                const f32x4 a0 = acc[ai][bj][m][0] + b0, a1 = acc[ai][bj][m][1] + b1; float o[8];
#pragma unroll
                for (int e = 0; e < 4; ++e) { o[e] = y[e] * sigm(a0[e]); o[4 + e] = y[4 + e] * sigm(a1[e]); }
                u32x4 w; w.x = cvt_pk_bf16(o[0], o[1]); w.y = cvt_pk_bf16(o[2], o[3]); w.z = cvt_pk_bf16(o[4], o[5]); w.w = cvt_pk_bf16(o[6], o[7]);
                *(u32x4*)(mix + (size_t)row * 1024 + 512 + col) = w; }
        }
    }
};
struct EpiResid {
    bf16_t* xb; float* ssq;
    __device__ __forceinline__ void operator()(const f32x4 (&acc)[2][2][4][2], const Unit& u, int wr, int wc, int fr, int fq) const {
        EPI_ROWCOL();
        EPI_FOR_ROWS() {
            const int row = row0 + ai * 128 + m * 16; float ss = 0.f;
#pragma unroll
            for (int bj = 0; bj < 2; ++bj) { const int col = col0 + bj * 128; const size_t off = (size_t)row * 1024 + col;
                const u32x4 xw = *(const u32x4*)(xb + off); float xo[8]; UNPACK8(xw, xo);
                const f32x4 x0 = (f32x4){xo[0], xo[1], xo[2], xo[3]} + acc[ai][bj][m][0], x1 = (f32x4){xo[4], xo[5], xo[6], xo[7]} + acc[ai][bj][m][1];
                ss += (x0[0] * x0[0] + x0[1] * x0[1]) + (x0[2] * x0[2] + x0[3] * x0[3]) + (x1[0] * x1[0] + x1[1] * x1[1]) + (x1[2] * x1[2] + x1[3] * x1[3]);
                u32x4 w; w.x = cvt_pk_bf16(x0[0], x0[1]); w.y = cvt_pk_bf16(x0[2], x0[3]); w.z = cvt_pk_bf16(x1[0], x1[1]); w.w = cvt_pk_bf16(x1[2], x1[3]);
                *(u32x4*)(xb + off) = w; }
            ss += __shfl_xor(ss, 16); ss += __shfl_xor(ss, 32);
            if (fq == 0) ssq[(size_t)row * 16 + u.pn * 4 + wc] = ss;
        }
    }
};

__device__ __forceinline__ void cvt_matrix(const float* W, int K, int N, bf16_t* Wt, const float* gk, int upperm, LAS float* tile, int bid, int G, int tid) {
    const int nst = N / 256, ntiles = (K / 64) * nst;
    for (int ti = bid; ti < ntiles; ti += G) {
        const int kt = ti / nst, ns = ti % nst;
        { const int r = tid >> 3, cb = (tid & 7) * 8; const float s = gk ? gk[kt * 64 + r] : 1.0f;
#pragma unroll
          for (int q = 0; q < 4; ++q) { const int c = cb + 64 * q; const float* src = W + (size_t)(kt * 64 + r) * N + ns * 256 + c;
              const f32x4 v0 = *(const f32x4*)src, v1 = *(const f32x4*)(src + 4);
              LAS float* d = tile + r * 257 + c; d[0] = v0[0] * s; d[1] = v0[1] * s; d[2] = v0[2] * s; d[3] = v0[3] * s; d[4] = v1[0] * s; d[5] = v1[1] * s; d[6] = v1[2] * s; d[7] = v1[3] * s; } }
        __syncthreads();
        { const int n = tid >> 1, ks = (tid & 1) * 32; int nd = ns * 256 + n;
          if (upperm == 1) { nd = (nd < DFF) ? ((nd >> 7) * 256 + (nd & 127)) : (((nd - DFF) >> 7) * 256 + 128 + ((nd - DFF) & 127)); }
          if (upperm == 3) { const int ar = nd >> 9, ch = nd & 511, c64 = ch & 63, slot = (ar == 0) ? 0 : (ar == 2) ? 1 : (ar == 1) ? 2 : 3;
              nd = (ch >> 6) * 256 + 128 * (slot >> 1) + 32 * (c64 >> 4) + 8 * ((c64 >> 2) & 3) + 4 * (slot & 1) + (c64 & 3); }
          if (upperm == 2) { nd = (nd < 512) ? ((nd >> 7) * 256 + (nd & 127)) : (nd < 1024) ? (nd + 512) : (nd < 1536) ? (((nd - 1024) >> 7) * 256 + 128 + ((nd - 1024) & 127)) : nd; }
#pragma unroll
          for (int q = 0; q < 4; ++q) { const LAS float* sp = tile + (ks + 8 * q) * 257 + n;
              u32x4 w; w.x = cvt_pk_bf16(sp[0], sp[257]); w.y = cvt_pk_bf16(sp[514], sp[771]); w.z = cvt_pk_bf16(sp[1028], sp[1285]); w.w = cvt_pk_bf16(sp[1542], sp[1799]);
              *(u32x4*)(Wt + (size_t)nd * K + kt * 64 + ks + 8 * q) = w; } }
        __syncthreads();
    }
}
__device__ __forceinline__ void s5_setup(PCP p, int j, int g, int part, LAS float* lds, int tid) {
    LAS float* PW = lds;
    LAS float* BB = lds + 2176;
    LAS float* CC = BB + 2048;
    LAS float* KT = CC + 2048;
    const int jg = j * 32 + g;
    const double st = exp((double)p->in[4][jg]);
    for (int e = tid; e < 64 * 17; e += 512) { const int pp = e / 17, k = e % 17; const double are = p->in[5][jg * 64 + pp], aim = p->in[6][jg * 64 + pp];
        const double mag = exp(are * st * k), ang = aim * st * k; PW[e * 2] = (float)(mag * cos(ang)); PW[e * 2 + 1] = (float)(mag * sin(ang)); }
    for (int e = tid; e < 64 * 16; e += 512) { const int pp = e >> 4, h = e & 15; const double are = p->in[5][jg * 64 + pp], aim = p->in[6][jg * 64 + pp];
        const double mag = exp(are * st), ang = aim * st; const double nr = mag * cos(ang) - 1.0, ni = mag * sin(ang); const double den = are * are + aim * aim;
        const double qr = (nr * are + ni * aim) / den, qi = (ni * are - nr * aim) / den;
        const double br = p->in[7][((size_t)jg * 64 + pp) * 16 + h], bi = p->in[8][((size_t)jg * 64 + pp) * 16 + h];
        BB[e * 2] = (float)(qr * br - qi * bi); BB[e * 2 + 1] = (float)(qr * bi + qi * br); }
    for (int e = tid; e < 1024; e += 512) { CC[e * 2] = p->in[9][(size_t)jg * 1024 + e]; CC[e * 2 + 1] = p->in[10][(size_t)jg * 1024 + e]; }
    if (tid < 64 && part == 0) { const double are = p->in[5][jg * 64 + tid], aim = p->in[6][jg * 64 + tid]; float* lq = (float*)(p->ws + WS_LQ) + (size_t)j * 8192;
        { const double mag = exp(are * st * 16.0), ang = aim * st * 16.0; lq[(g * 64 + tid) * 2] = (float)(mag * cos(ang)); lq[(g * 64 + tid) * 2 + 1] = (float)(mag * sin(ang)); }
        { const double mag = exp(are * st * 512.0), ang = aim * st * 512.0; lq[4096 + (g * 64 + tid) * 2] = (float)(mag * cos(ang)); lq[4096 + (g * 64 + tid) * 2 + 1] = (float)(mag * sin(ang)); } }
    __syncthreads();
    for (int e = tid; e < 4096; e += 512) { const int tau = e >> 8, hp = (e >> 4) & 15, h = e & 15; float s = 0.f;
        for (int pp = 0; pp < 64; ++pp) { const float cr = CC[(hp * 64 + pp) * 2], ci = CC[(hp * 64 + pp) * 2 + 1], pr = PW[(pp * 17 + tau) * 2], pi = PW[(pp * 17 + tau) * 2 + 1];
            const float xr = cr * pr - ci * pi, xi = cr * pi + ci * pr; s += xr * BB[(pp * 16 + h) * 2] - xi * BB[(pp * 16 + h) * 2 + 1]; }
        KT[e] = s; }
    __syncthreads();
    bf16_t* mct = (bf16_t*)(p->ws + WS_MCT + (size_t)j * 6 * MiB) + (size_t)g * 256 * 384;
    for (int e = tid + part * 512; e < 256 * 384; e += 2048) { const int n = e / 384, k = e % 384, t = n >> 4, hp = n & 15; float v;
        if (k < 256) { const int s = k >> 4, h = k & 15; v = (s <= t) ? KT[((t - s) * 16 + hp) * 16 + h] : 0.f; }
        else { const int jj = k - 256, pp = jj & 63; const float cr = CC[(hp * 64 + pp) * 2], ci = CC[(hp * 64 + pp) * 2 + 1], pr = PW[(pp * 17 + t + 1) * 2], pi = PW[(pp * 17 + t + 1) * 2 + 1];
            v = (jj < 64) ? (cr * pr - ci * pi) : -(cr * pi + ci * pr); }
        mct[e] = f2bf(v); }
    bf16_t* bct = (bf16_t*)(p->ws + WS_BCT2 + (size_t)j * 4 * MiB) + (size_t)g * 256 * 256;
    for (int e = tid + part * 512; e < 128 * 256; e += 2048) bct[128 * 256 + e] = 0;
    for (int e = tid + part * 512; e < 128 * 256; e += 2048) { const int jj = e >> 8, k = e & 255, s = k >> 4, h = k & 15, pp = jj & 63;
        const float pr = PW[(pp * 17 + 15 - s) * 2], pi = PW[(pp * 17 + 15 - s) * 2 + 1], br = BB[(pp * 16 + h) * 2], bi = BB[(pp * 16 + h) * 2 + 1];
        bct[e] = f2bf((jj < 64) ? (pr * br - pi * bi) : (pr * bi + pi * br)); }
    __syncthreads();
}

__device__ __forceinline__ bf16_t* wl(PCP p, int i, size_t off) { return (bf16_t*)(p->ws + WS_W + (size_t)i * WL_STRIDE + off); }

__device__ __forceinline__ void phase0(PCP p, LAS unsigned char* lds, int bid, int G, int tid) {
    tid = opq(tid); p = opqp(p);
    LAS float* tile = (LAS float*)lds;
    const int wid = tid >> 6, lane = tid & 63;
    for (int i = 0; i < 4; ++i) {
        const int j = i >> 1;
        if ((i & 1) == 0) cvt_matrix(p->in[2] + (size_t)j * 1024 * 2048, 1024, 2048, wl(p, i, 0), p->in[1] + i * 1024, 3, tile, bid, G, tid);
        else              cvt_matrix(p->in[15] + (size_t)j * 1024 * 1536, 1024, 1536, wl(p, i, 0), p->in[1] + i * 1024, 0, tile, bid, G, tid);
        cvt_matrix(((i & 1) == 0 ? p->in[14] : p->in[21]) + (size_t)j * 1024 * 1024, 1024, 1024, wl(p, i, 4 * MiB), nullptr, 0, tile, bid, G, tid);
        cvt_matrix(p->in[23] + (size_t)i * 1024 * NUP, 1024, NUP, wl(p, i, 6 * MiB), p->in[22] + i * 1024, 1, tile, bid, G, tid);
        cvt_matrix(p->in[26] + (size_t)i * DFF * 1024, DFF, 1024, wl(p, i, 17 * MiB), nullptr, 0, tile, bid, G, tid);
    }
    for (int j = 0; j < 2; ++j) {
        cvt_matrix(p->in[12] + (size_t)j * 512 * 512, 512, 512, (bf16_t*)(p->ws + WS_GLU + (size_t)j * 512 * 1024), nullptr, 0, tile, bid, G, tid);
        { bf16_t* pwbd = (bf16_t*)(p->ws + WS_PWBD + (size_t)j * 512 * 1024); bf16_t* wsbd = (bf16_t*)(p->ws + WS_WSBD + (size_t)j * 512 * 1024);
          for (int e = bid * 512 + tid; e < 512 * 512; e += G * 512) { const int n = e >> 9, k = e & 511, gn = n >> 7, gk2 = k >> 7;
              pwbd[e] = f2bf(gn == gk2 ? p->in[16][(((size_t)j * 4 + gn) * 128 + (k & 127)) * 128 + (n & 127)] * p->in[17][j * 512 + n] : 0.f);
              wsbd[e] = f2bf((gn == gk2 && (k & 127) <= (n & 127)) ? p->in[19][(((size_t)j * 4 + gn) * 128 + (n & 127)) * 128 + (k & 127)] : 0.f); } }
    }
    for (int it = bid; it < 256; it += G) s5_setup(p, it >> 7, (it >> 2) & 31, it & 3, (LAS float*)lds, tid);
    { const float* x = p->in[0]; bf16_t* xb = (bf16_t*)(p->ws + WS_XB); float* ssq = (float*)(p->ws + WS_SSQ) + (size_t)16 * T;
      for (int row0 = (bid * 8 + wid) * 4; row0 < T; row0 += G * 8 * 4) { float ss[4]; f32x4 va[4][2], vb[4][2];
#pragma unroll
          for (int r = 0; r < 4; ++r)
#pragma unroll
              for (int h = 0; h < 2; ++h) { const float* xp = x + (size_t)(row0 + r) * 1024 + h * 512 + lane * 8; va[r][h] = *(const f32x4*)xp; vb[r][h] = *(const f32x4*)(xp + 4); }
#pragma unroll
          for (int r = 0; r < 4; ++r) { ss[r] = 0.f;
#pragma unroll
              for (int h = 0; h < 2; ++h) { const f32x4 a = va[r][h], b = vb[r][h];
                  ss[r] += (a[0] * a[0] + a[1] * a[1]) + (a[2] * a[2] + a[3] * a[3]) + (b[0] * b[0] + b[1] * b[1]) + (b[2] * b[2] + b[3] * b[3]);
                  u32x4 w; w.x = cvt_pk_bf16(a[0], a[1]); w.y = cvt_pk_bf16(a[2], a[3]); w.z = cvt_pk_bf16(b[0], b[1]); w.w = cvt_pk_bf16(b[2], b[3]);
                  *(u32x4*)(xb + (size_t)(row0 + r) * 1024 + h * 512 + lane * 8) = w; }
              ss[r] = wave_sum(ss[r]); if (lane < 16) ssq[(size_t)(row0 + r) * 16 + lane] = (lane == 0) ? ss[r] : 0.f; } } }
}

__device__ __forceinline__ void phase_evenfix(PCP p, int j, int bid, int G, int tid) {
    tid = opq(tid); p = opqp(p);
    const float* head = (const float*)(p->ws + WS_HEAD); const float* tail = (const float*)(p->ws + WS_TAIL); bf16_t* mix = (bf16_t*)(p->ws + WS_MIX); const float* cw = p->in[3] + (size_t)j * 3 * 512;
    for (int idx = bid * 512 + tid; idx < 128 * 2 * 128; idx += G * 512) {
        const int pm = idx >> 8, r = (idx >> 7) & 1, c = (idx & 127) * 4;
        if ((pm & 15) == 0) continue;
        const f32x4 q0 = *(const f32x4*)(head + (((size_t)pm * 2 + r) * 2 + 0) * 512 + c), ba = *(const f32x4*)(head + (((size_t)pm * 2 + r) * 2 + 1) * 512 + c);
        const f32x4 q1 = (r == 1) ? *(const f32x4*)(head + (((size_t)pm * 2 + 0) * 2 + 0) * 512 + c) : *(const f32x4*)(tail + ((size_t)(pm - 1) * 2 + 1) * 512 + c);
        const f32x4 q2 = (r == 1) ? *(const f32x4*)(tail + ((size_t)(pm - 1) * 2 + 1) * 512 + c) : *(const f32x4*)(tail + ((size_t)(pm - 1) * 2 + 0) * 512 + c);
        const f32x4 ya = ba * (*(const f32x4*)(cw + c) * q2 + *(const f32x4*)(cw + 512 + c) * q1 + *(const f32x4*)(cw + 1024 + c) * q0);
        u32x2 w; w.x = cvt_pk_bf16(ya[0], ya[1]); w.y = cvt_pk_bf16(ya[2], ya[3]);
        *(u32x2*)(mix + ((size_t)pm * 256 + r) * 1024 + c) = w;
    }
}
__device__ __forceinline__ void phase_s5(PCP p, int j, LAS float* lds, int bid, int G, int tid) {
    tid = opq(tid); p = opqp(p);
    const int wid = tid >> 6, lane = tid & 63;
    bf16_t* a2 = (bf16_t*)(p->ws + WS_A2); float* sloc = (float*)(p->ws + WS_SLOC); const float* lq = (const float*)(p->ws + WS_LQ) + (size_t)j * 8192;
    const bf16_t* bct = (const bf16_t*)(p->ws + WS_BCT + (size_t)j * 2 * MiB); const bf16_t* mct = (const bf16_t*)(p->ws + WS_MCT + (size_t)j * 6 * MiB); bf16_t* yg = (bf16_t*)(p->ws + WS_YG);
    for (int it = bid; it < 256; it += G) { const int b = it >> 5, g = it & 31;
        const size_t rowb = (size_t)g * 2048 + b * 256;
        { const float ar = lq[(g * 64 + lane) * 2], ai = lq[(g * 64 + lane) * 2 + 1], br = lq[4096 + (g * 64 + lane) * 2], bi = lq[4096 + (g * 64 + lane) * 2 + 1];
          const size_t row0 = rowb + wid * 32;
          float xr[32], xi[32];
#pragma unroll
          for (int c = 0; c < 32; ++c) { xr[c] = sloc[(row0 + c) * 128 + lane]; xi[c] = sloc[(row0 + c) * 128 + 64 + lane]; }
          float sr = 0.f, si = 0.f;
#pragma unroll
          for (int c = 0; c < 32; ++c) { const float nr = ar * sr - ai * si + xr[c], ni = ar * si + ai * sr + xi[c]; sr = nr; si = ni; }
          lds[(wid * 64 + lane) * 2] = sr; lds[(wid * 64 + lane) * 2 + 1] = si;
          __syncthreads();
          sr = 0.f; si = 0.f;
          for (int v = 0; v < wid; ++v) { const float er = lds[(v * 64 + lane) * 2], ei = lds[(v * 64 + lane) * 2 + 1]; const float nr = br * sr - bi * si + er, ni = br * si + bi * sr + ei; sr = nr; si = ni; }
#pragma unroll
          for (int c = 0; c < 32; ++c) { a2[(row0 + c) * 384 + 256 + lane] = f2bf(sr); a2[(row0 + c) * 384 + 320 + lane] = f2bf(si);
              const float nr = ar * sr - ai * si + xr[c], ni = ar * si + ai * sr + xi[c]; sr = nr; si = ni; } }
        __syncthreads();
    }
}
__device__ __forceinline__ void pool_chunk(PCP p, int chunk, int tid) {
    const bf16_t* proj = (const bf16_t*)(p->ws + WS_PROJ); bf16_t* pooled = (bf16_t*)(p->ws + WS_A2);
    { const int idx = chunk * 512 + tid;
        const int t0 = (idx >> 6) * 16, c = (idx & 63) * 8, pos0 = t0 & (SEQ - 1), w = 2 << (c >> 7);
        float s[8];
#pragma unroll
        for (int e = 0; e < 8; ++e) s[e] = 0.f;
#pragma unroll
        for (int k = 1; k < 16; ++k) { if (k < w && k <= pos0) { const u32x4 zw = *(const u32x4*)(proj + (size_t)(t0 - k) * 1536 + c); float q[8]; UNPACK8(zw, q);
#pragma unroll
            for (int e = 0; e < 8; ++e) s[e] += q[e]; } }
#pragma unroll
        for (int i = 0; i < 16; ++i) { const int t = t0 + i, pos = pos0 + i;
            const u32x4 zw = *(const u32x4*)(proj + (size_t)t * 1536 + c); float z[8]; UNPACK8(zw, z);
#pragma unroll
            for (int e = 0; e < 8; ++e) s[e] += z[e];
            const int cnt = (pos + 1 < w) ? pos + 1 : w; const float inv = 1.0f / (float)cnt;
            u32x4 o; o.x = cvt_pk_bf16(s[0] * inv - z[0], s[1] * inv - z[1]); o.y = cvt_pk_bf16(s[2] * inv - z[2], s[3] * inv - z[3]); o.z = cvt_pk_bf16(s[4] * inv - z[4], s[5] * inv - z[5]); o.w = cvt_pk_bf16(s[6] * inv - z[6], s[7] * inv - z[7]);
            *(u32x4*)(pooled + (size_t)t * 512 + c) = o;
            if (pos + 1 >= w) { const u32x4 ow = *(const u32x4*)(proj + (size_t)(t + 1 - w) * 1536 + c); float q[8]; UNPACK8(ow, q);
#pragma unroll
                for (int e = 0; e < 8; ++e) s[e] -= q[e]; } }
    }
}
__device__ __forceinline__ void sguprep_chunk(PCP p, int j, LAS unsigned char* lds, int it, int tid) {
    const int wid = tid >> 6, lane = tid & 63;
    const bf16_t* proj = (const bf16_t*)(p->ws + WS_PROJ); bf16_t* vt = (bf16_t*)(p->ws + WS_SLOC); const float* ng = p->in[18] + (size_t)j * 512;
    LAS float* rstd = (LAS float*)lds; LAS bf16_t* tl = (LAS bf16_t*)(lds + 1024);
    { const size_t T0 = (size_t)it * 128;
#pragma unroll
        for (int s0 = 0; s0 < 16; ++s0) { const int s = wid * 16 + s0; const u32x4 vw = *(const u32x4*)(proj + (T0 + s) * 1536 + 1024 + lane * 8); float v[8]; UNPACK8(vw, v); float ss = 0.f;
#pragma unroll
            for (int e = 0; e < 8; ++e) ss += v[e] * v[e];
            ss = wave_sum(ss); if (lane == 0) rstd[s] = rsqrtf(ss * (1.0f / 512.0f) + EPS); }
        __syncthreads();
        for (int h = 0; h < 4; ++h) {
            const int d0 = (tid & 15) * 8; const f32x4 g0 = *(const f32x4*)(ng + h * 128 + d0), g1 = *(const f32x4*)(ng + h * 128 + d0 + 4);
#pragma unroll
            for (int i = 0; i < 4; ++i) { const int s = (tid >> 4) + 32 * i; const u32x4 vw = *(const u32x4*)(proj + (T0 + s) * 1536 + 1024 + h * 128 + d0); float v[8]; UNPACK8(vw, v); const float rs = rstd[s];
#pragma unroll
                for (int e = 0; e < 4; ++e) { tl[(d0 + e) * 130 + s] = f2bf(v[e] * rs * g0[e]); tl[(d0 + 4 + e) * 130 + s] = f2bf(v[4 + e] * rs * g1[e]); } }
            __syncthreads();
#pragma unroll
            for (int i = 0; i < 4; ++i) { const int d = (tid >> 4) + 32 * i, s0 = (tid & 15) * 8; const LAS unsigned* src = (const LAS unsigned*)(tl + d * 130 + s0);
                u32x4 w; w.x = src[0]; w.y = src[1]; w.z = src[2]; w.w = src[3];
                *(u32x4*)(vt + ((size_t)it * 128 + d) * 512 + h * 128 + s0) = w; }
            __syncthreads();
        }
    }
}
__device__ __forceinline__ void phase_odd(PCP p, int j, LAS unsigned char* lds, int bid, int G, int tid) {
    tid = opq(tid); p = opqp(p);
    for (int it = bid; it < 256; it += G) {
        pool_chunk(p, it, tid);
        sguprep_chunk(p, j, lds, it, tid);
        __syncthreads();
    }
}
__device__ __forceinline__ void ffnfix_panel(PCP p, int i, int pm, int tid) {
    if ((pm & 15) == 0) return;
    const float* head = (const float*)(p->ws + WS_HEAD); const float* tail = (const float*)(p->ws + WS_TAIL); bf16_t* act = (bf16_t*)(p->ws + WS_ACT);
    const float* cw = p->in[24] + (size_t)i * 3 * NUP; const float* cb = p->in[25] + (size_t)i * NUP;
    for (int idx = tid; idx < 2 * 704; idx += 512) {
        const int r = idx / 704, c = (idx - r * 704) * 4;
        const float* h0 = head + ((size_t)pm * 2) * NUP; const float* t0 = tail + ((size_t)(pm - 1) * 2) * NUP;
        const float* r0 = (r == 1) ? h0 + NUP : h0;
        const float* r1 = (r == 1) ? h0 : t0 + NUP;
        const float* r2 = (r == 1) ? t0 + NUP : t0;
        const f32x4 g = *(const f32x4*)(cb + c) + *(const f32x4*)(cw + c) * *(const f32x4*)(r2 + c) + *(const f32x4*)(cw + NUP + c) * *(const f32x4*)(r1 + c) + *(const f32x4*)(cw + 2 * NUP + c) * *(const f32x4*)(r0 + c);
        const f32x4 v = *(const f32x4*)(cb + DFF + c) + *(const f32x4*)(cw + DFF + c) * *(const f32x4*)(r2 + DFF + c) + *(const f32x4*)(cw + NUP + DFF + c) * *(const f32x4*)(r1 + DFF + c) + *(const f32x4*)(cw + 2 * NUP + DFF + c) * *(const f32x4*)(r0 + DFF + c);
        u32x2 w; w.x = cvt_pk_bf16(g[0] * sigm(g[0]) * v[0], g[1] * sigm(g[1]) * v[1]); w.y = cvt_pk_bf16(g[2] * sigm(g[2]) * v[2], g[3] * sigm(g[3]) * v[3]);
        *(u32x2*)(act + ((size_t)pm * 256 + r) * DFF + c) = w;
    }
}
__device__ __forceinline__ void phase_final(PCP p, int bid, int G, int tid) {
    tid = opq(tid); p = opqp(p);
    const int wid = tid >> 6, lane = tid & 63; const float* ssq = (const float*)(p->ws + WS_SSQ) + (size_t)16 * T; const float* gf = p->in[27]; const bf16_t* xb = (const bf16_t*)(p->ws + WS_XB);
    for (int row = bid * 8 + wid; row < T; row += G * 8) { float sq = (lane < 16) ? ssq[(size_t)row * 16 + lane] : 0.f; sq = wave_sum(sq); const float rs = rsqrtf(sq * (1.0f / 1024.0f) + EPS);
#pragma unroll
        for (int q = 0; q < 2; ++q) { const int c = q * 512 + lane * 8; const u32x4 xw = *(const u32x4*)(xb + (size_t)row * 1024 + c); float x[8]; UNPACK8(xw, x);
            const f32x4 g0 = *(const f32x4*)(gf + c), g1 = *(const f32x4*)(gf + c + 4);
            *(f32x4*)(p->out + (size_t)row * 1024 + c) = (f32x4){x[0], x[1], x[2], x[3]} * rs * g0; *(f32x4*)(p->out + (size_t)row * 1024 + c + 4) = (f32x4){x[4], x[5], x[6], x[7]} * rs * g1; } }
}

#define GSYNC() xcd_barrier(xbar)
__global__ void __launch_bounds__(512, 2) mega(P parg) {
    extern __shared__ __attribute__((aligned(16))) unsigned char lds_raw[];
    LAS unsigned char* lds = (LAS unsigned char*)lds_raw;
    PCP p = (PCP)__builtin_amdgcn_kernarg_segment_ptr();
    if (parg.ws == nullptr) cg::this_grid().sync();
    const int tid = threadIdx.x, bid = blockIdx.x, G = gridDim.x;
    unsigned char* ws = p->ws;
    float* ssq0 = (float*)(ws + WS_SSQ); float* ssq1 = ssq0 + (size_t)16 * T;
    bf16_t* xb = (bf16_t*)(ws + WS_XB); bf16_t* proj = (bf16_t*)(ws + WS_PROJ); bf16_t* mix = (bf16_t*)(ws + WS_MIX); bf16_t* a2 = (bf16_t*)(ws + WS_A2); bf16_t* yg = (bf16_t*)(ws + WS_YG);
    bf16_t* act = (bf16_t*)(ws + WS_ACT);

    if (tid < 4) ((LAS unsigned*)(lds + LDS_BARW))[tid] = 0u;
    __syncthreads();
    XcdBarrier xbar = xcd_barrier_post((unsigned*)(ws + WS_BAR), (volatile LAS unsigned*)(lds + LDS_BARW));
    phase0(p, lds, bid, G, tid);
    GSYNC();
    for (int i = 0; i < 4; ++i) {
        const int j = i >> 1;
        if ((i & 1) == 0) {
            { pg8::Gemm g{xb, wl(p, i, 0), T, 2048, 1024, 1024, 1024}; pg8::StaticOrder S; S.init(T, 2048, G, bid); EpiProjEven4 E{mix, a2, ssq1, p->in[3] + (size_t)j * 3 * 512, (float*)(ws + WS_HEAD), (float*)(ws + WS_TAIL), (LAS float*)(lds + LDS_HALO)}; pg8::gemm_phase(lds, g, S, E);
            }
            GSYNC();
            { int k256 = 256; asm volatile("" : "+s"(k256));
              pg8::Gemm g{a2, (const bf16_t*)(ws + WS_BCT2 + (size_t)j * 4 * MiB), 65536, 8192, k256, 384, 256}; pg8::StaticOrder S; S.init_diag(256, G, bid); EpiS5a E{(float*)(ws + WS_SLOC)}; pg8::gemm_phase(lds, g, S, E); }
            GSYNC();
            phase_evenfix(p, j, bid, G, tid); phase_s5(p, j, (LAS float*)lds, bid, G, tid);
            GSYNC();
            { int k384 = 384; asm volatile("" : "+s"(k384));
              pg8::Gemm g{a2, (const bf16_t*)(ws + WS_MCT + (size_t)j * 6 * MiB), 65536, 8192, k384, 384, 384}; pg8::StaticOrder S; S.init_diag(256, G, bid); EpiS5c E{a2, p->in[11] + (size_t)j * 512, yg}; pg8::gemm_phase(lds, g, S, E); }
            GSYNC();
            { pg8::Gemm g{yg, (const bf16_t*)(ws + WS_GLU + (size_t)j * 512 * 1024), T, 512, 512, 512, 512}; pg8::StaticOrder S; S.init(T, 512, G, bid); EpiGlu E{yg, mix, p->in[13] + (size_t)j * 512}; pg8::gemm_phase(lds, g, S, E);
            }
            GSYNC();
        } else {
            { pg8::Gemm g{xb, wl(p, i, 0), T, 1536, 1024, 1024, 1024}; pg8::StaticOrder S; S.init(T, 1536, G, bid); EpiProjOdd E{proj, ssq1}; pg8::gemm_phase(lds, g, S, E);
            }
            GSYNC();
            phase_odd(p, j, lds, bid, G, tid);
            GSYNC();
            { int k512 = 512; asm volatile("" : "+s"(k512));
              { pg8::Gemm g{(const bf16_t*)(ws + WS_A2), (const bf16_t*)(ws + WS_PWBD + (size_t)j * 512 * 1024), T, 512, k512, 512, 512}; pg8::StaticOrder S; S.init(T, 512, G, bid); EpiPoolOut E{mix}; pg8::gemm_phase(lds, g, S, E); }
              { pg8::Gemm g{(const bf16_t*)(ws + WS_WSBD + (size_t)j * 512 * 1024), (const bf16_t*)(ws + WS_SLOC), 512, T, k512, 512, 512}; pg8::StaticOrder S; S.init(512, T, G, bid); EpiSguOut E{proj, p->in[20] + (size_t)j * 512, mix}; pg8::gemm_phase(lds, g, S, E); } }
            GSYNC();
        }
        { pg8::Gemm g{mix, wl(p, i, 4 * MiB), T, 1024, 1024, 1024, 1024}; pg8::StaticOrder S; S.init(T, 1024, G, bid);
          EpiResid E{xb, ssq0}; pg8::gemm_phase(lds, g, S, E);
        }
        GSYNC();
        { pg8::Gemm g{xb, wl(p, i, 6 * MiB), T, NUP, 1024, 1024, 1024}; pg8::StaticOrder S; S.init(T, NUP, G, bid);
          EpiUpFused E{act, ssq0, p->in[24] + (size_t)i * 3 * NUP, p->in[25] + (size_t)i * NUP, (float*)(ws + WS_HEAD), (float*)(ws + WS_TAIL), (LAS float*)(lds + LDS_HALO)}; pg8::gemm_phase(lds, g, S, E);
        }
        GSYNC();
        { pg8::Gemm g{act, wl(p, i, 17 * MiB), T, 1024, DFF, DFF, DFF}; pg8::StaticOrder S; S.init(T, 1024, G, bid); EpiResid E{xb, ssq1};
          { const int t2 = opq(tid); Unit fu; for (int ui = 0; S.next(ui, fu); ++ui) ffnfix_panel(p, i, fu.pm, t2); asm volatile("s_waitcnt vmcnt(0)" ::: "memory"); __syncthreads(); }
          pg8::gemm_phase(lds, g, S, E);
        }
        GSYNC();
    }
    phase_final(p, bid, G, tid);
}

extern "C" void kernel_launch(void* const* d_in, const int* in_sizes, int n_in, void* d_out, int out_size, void* d_ws, size_t ws_size, hipStream_t stream) {
    static int grid = 0;
    if (grid == 0) {
        if (n_in != 28 || out_size != T * D || ws_size < WS_END) { fprintf(stderr, "kernel_launch: unexpected shapes (n_in %d, out %d, ws %zu < %zu)\n", n_in, out_size, ws_size, (size_t)WS_END); }
        int dev = 0, cus = 0, per_cu = 0;
        hipGetDevice(&dev); hipDeviceGetAttribute(&cus, hipDeviceAttributeMultiprocessorCount, dev);
        hipFuncSetAttribute((const void*)mega, hipFuncAttributeMaxDynamicSharedMemorySize, LDS_BYTES);
        hipOccupancyMaxActiveBlocksPerMultiprocessor(&per_cu, (const void*)mega, 512, LDS_BYTES);
        (void)hipGetLastError();
        grid = cus > 0 ? cus : 256;
        if (per_cu < 1) fprintf(stderr, "kernel_launch: occupancy query reports %d blocks per CU\n", per_cu);
    }
    (void)hipMemsetAsync((char*)d_ws + WS_BAR, 0, 16384, stream);
    P p{};
    for (int i = 0; i < 28; ++i) p.in[i] = (const float*)d_in[i];
    p.out = (float*)d_out; p.ws = (unsigned char*)d_ws;
    void* args[] = {&p};
    hipError_t e = hipLaunchCooperativeKernel((const void*)mega, dim3(grid), dim3(512), args, LDS_BYTES, stream);
    if (e != hipSuccess) fprintf(stderr, "cooperative launch failed: %s (grid %d)\n", hipGetErrorString(e), grid);
}
```
